# Optimizing an MI355X kernel written in HIP

```python
import math
import jax
import jax.numpy as jnp
from jax import lax
import numpy as np


D_MODEL = 1024
BATCH = 16
SEQ = 2048
DEPTH = 4

HEAD_DIM = 64
MLA_HEADS = 8
MLA_NOPE = 64
MLA_ROPE = 32
MLA_V = 64
MLA_Q_LORA = 384
MLA_KV_LORA = 256
ROPE_THETA = 10000.0
MOBA_HEADS = 8
MOBA_BLOCK = 256
MOBA_TOPK = 3
MOBA_QCHUNK = 32
SB_HEADS = 16
Q_BLOCK = 128
NUM_BUCKETS = 32
MAX_DISTANCE = 128
RMS_EPS = 1e-6
D_FF = -(-8 * D_MODEL // (3 * 256)) * 256
N_EVEN = (DEPTH + 1) // 2
N_ODD = DEPTH // 2
AB_IN = MLA_Q_LORA + MLA_KV_LORA + MLA_ROPE + 3 * MOBA_HEADS * HEAD_DIM
AB_OUT = MLA_HEADS * MLA_V + MOBA_HEADS * HEAD_DIM
SB_WIDTH = SB_HEADS * HEAD_DIM

kernel_name = 'hybrid_mla_moba_stickbreaking'


def rmsnorm(x, g):
    xf = x.astype(jnp.float32)
    y = xf * lax.rsqrt(jnp.mean(xf * xf, axis=-1, keepdims=True) + RMS_EPS)
    return (y * g.astype(jnp.float32)).astype(x.dtype)


def rope(x, pos):
    half = x.shape[-1] // 2
    inv_freq = ROPE_THETA ** (-jnp.arange(half, dtype=jnp.float32) / half)
    ang = pos.astype(jnp.float32)[:, None] * inv_freq[None, :]
    cos, sin = jnp.cos(ang), jnp.sin(ang)
    x1 = x[..., :half].astype(jnp.float32)
    x2 = x[..., half:].astype(jnp.float32)
    return jnp.concatenate([x1 * cos - x2 * sin, x1 * sin + x2 * cos], axis=-1).astype(x.dtype)


def t5_bucket(rel):
    max_exact = NUM_BUCKETS // 2
    rel = jnp.maximum(rel, 0)
    large = max_exact + (jnp.log(jnp.maximum(rel, max_exact).astype(jnp.float32) / max_exact)
                         / math.log(MAX_DISTANCE / max_exact) * (NUM_BUCKETS - max_exact)).astype(jnp.int32)
    large = jnp.minimum(large, NUM_BUCKETS - 1)
    return jnp.where(rel < max_exact, rel, large)


def mla_attention(c_q, c_kv, k_rope_in, q_norm_g, w_uq, kv_norm_g, w_ukv, pos):
    B, S, _ = c_q.shape
    q = jnp.einsum('bsr,rhd->bhsd', rmsnorm(c_q, q_norm_g),
                   w_uq.reshape(MLA_Q_LORA, MLA_HEADS, MLA_NOPE + MLA_ROPE))
    q_nope = q[..., :MLA_NOPE]
    q_rope = rope(q[..., MLA_NOPE:], pos)
    kv = jnp.einsum('bsr,rhd->bhsd', rmsnorm(c_kv, kv_norm_g),
                    w_ukv.reshape(MLA_KV_LORA, MLA_HEADS, MLA_NOPE + MLA_V))
    k_nope, v = kv[..., :MLA_NOPE], kv[..., MLA_NOPE:]
    k_rope = rope(k_rope_in, pos)
    scale = (MLA_NOPE + MLA_ROPE) ** -0.5
    n_blk = S // Q_BLOCK
    qn = q_nope.reshape(B, MLA_HEADS, n_blk, Q_BLOCK, MLA_NOPE).transpose(2, 0, 1, 3, 4)
    qr = q_rope.reshape(B, MLA_HEADS, n_blk, Q_BLOCK, MLA_ROPE).transpose(2, 0, 1, 3, 4)
    kpos = jnp.arange(S)

    def block(args):
        i, qn_b, qr_b = args
        logits = (jnp.einsum('bhqd,bhkd->bhqk', qn_b, k_nope)
                  + jnp.einsum('bhqd,bkd->bhqk', qr_b, k_rope)).astype(jnp.float32) * scale
        qpos = i * Q_BLOCK + jnp.arange(Q_BLOCK)
        logits = jnp.where(kpos[None, :] <= qpos[:, None], logits, -jnp.inf)
        p = jax.nn.softmax(logits, axis=-1).astype(v.dtype)
        return jnp.einsum('bhqk,bhkd->bhqd', p, v)

    out = lax.map(block, (jnp.arange(n_blk), qn, qr))
    return out.transpose(1, 0, 3, 2, 4).reshape(B, S, MLA_HEADS * MLA_V)


def moba_attention(q, k, v, rel_bias):
    B, H, S, d = q.shape
    nb = -(-S // MOBA_BLOCK)
    pad = nb * MOBA_BLOCK - S
    kp = jnp.pad(k, ((0, 0), (0, 0), (0, pad), (0, 0)))
    vp = jnp.pad(v, ((0, 0), (0, 0), (0, pad), (0, 0)))
    kb = kp.reshape(B, H, nb, MOBA_BLOCK, d)
    vb = vp.reshape(B, H, nb, MOBA_BLOCK, d)
    kbar = jnp.mean(kb.astype(jnp.float32), axis=3).astype(k.dtype)
    kk = min(MOBA_TOPK, max(nb - 1, 1))
    scale = d ** -0.5
    n_chunk = S // MOBA_QCHUNK
    qc_all = q.reshape(B, H, n_chunk, MOBA_QCHUNK, d).transpose(2, 0, 1, 3, 4)
    b_idx = jnp.arange(B)[:, None, None, None]
    h_idx = jnp.arange(H)[None, :, None, None]
    bias_t = rel_bias.T
    offs = jnp.arange(MOBA_BLOCK)

    def chunk(args):
        i, q_c = args
        qpos = i * MOBA_QCHUNK + jnp.arange(MOBA_QCHUNK)
        own = (i * MOBA_QCHUNK) // MOBA_BLOCK
        gate = jnp.einsum('bhqd,bhnd->bhqn', q_c, kbar).astype(jnp.float32)
        gate = jnp.where(jnp.arange(nb) < own, gate, -jnp.inf)
        _, idx = lax.top_k(gate, kk)
        valid = idx < own
        kg = kb[b_idx, h_idx, idx]
        vg = vb[b_idx, h_idx, idx]
        rel_sel = qpos[None, None, :, None, None] - (idx[..., None] * MOBA_BLOCK + offs)
        bias_sel = bias_t[h_idx[..., None], t5_bucket(rel_sel)].astype(jnp.float32)
        l_sel = jnp.einsum('bhqd,bhqknd->bhqkn', q_c, kg).astype(jnp.float32) * scale + bias_sel
        l_sel = jnp.where(valid[..., None], l_sel, -jnp.inf)
        k_own = lax.dynamic_slice_in_dim(kp, own * MOBA_BLOCK, MOBA_BLOCK, axis=2)
        v_own = lax.dynamic_slice_in_dim(vp, own * MOBA_BLOCK, MOBA_BLOCK, axis=2)
        rel_own = qpos[:, None] - (own * MOBA_BLOCK + offs)[None, :]
        bias_own = jnp.transpose(rel_bias[t5_bucket(rel_own)], (2, 0, 1)).astype(jnp.float32)
        l_own = jnp.einsum('bhqd,bhnd->bhqn', q_c, k_own).astype(jnp.float32) * scale + bias_own
        l_own = jnp.where(rel_own >= 0, l_own, -jnp.inf)
        logits = jnp.concatenate([l_sel.reshape(B, H, MOBA_QCHUNK, kk * MOBA_BLOCK), l_own], axis=-1)
        p = jax.nn.softmax(logits, axis=-1).astype(v.dtype)
        p_sel = p[..., :kk * MOBA_BLOCK].reshape(B, H, MOBA_QCHUNK, kk, MOBA_BLOCK)
        p_own = p[..., kk * MOBA_BLOCK:]
        return (jnp.einsum('bhqkn,bhqknd->bhqd', p_sel, vg)
                + jnp.einsum('bhqn,bhnd->bhqd', p_own, v_own))

    out = lax.map(chunk, (jnp.arange(n_chunk), qc_all))
    return out.transpose(1, 0, 3, 2, 4).reshape(B, S, H * d)


def stick_breaking_attention(q, k, v):
    B, H, S, d = q.shape
    scale = d ** -0.5
    n_blk = S // Q_BLOCK
    qb = q.reshape(B, H, n_blk, Q_BLOCK, d).transpose(2, 0, 1, 3, 4)
    kpos = jnp.arange(S)

    def block(args):
        i, q_b = args
        qpos = i * Q_BLOCK + jnp.arange(Q_BLOCK)
        strict = kpos[None, :] < qpos[:, None]
        z = jnp.einsum('bhqd,bhkd->bhqk', q_b, k).astype(jnp.float32) * scale
        log_beta = jax.nn.log_sigmoid(z)
        log_1m = jnp.where(strict, jax.nn.log_sigmoid(-z), 0.0)
        acc = lax.cumsum(log_1m, axis=3, reverse=True) - log_1m
        w = jnp.where(strict, jnp.exp(log_beta + acc), 0.0)
        return jnp.einsum('bhqk,bhkd->bhqd', w.astype(v.dtype), v)

    out = lax.map(block, (jnp.arange(n_blk), qb))
    return out.transpose(1, 0, 3, 2, 4).reshape(B, S, H * d)


def setup_inputs(seed: int = 0) -> dict:
    key = jax.random.key(seed)
    ks = jax.random.split(key, 17)

    def nrm(k, shape, fan_in):
        return jax.random.normal(k, shape, jnp.float32) * (fan_in ** -0.5)

    def gain(k, shape):
        return 1.0 + 0.05 * jax.random.normal(k, shape, jnp.float32)

    return {
        'x': jax.random.normal(ks[0], (BATCH, SEQ, D_MODEL), jnp.float32),
        'mix_pre_g': gain(ks[1], (DEPTH, D_MODEL)),
        'mix_post_g': gain(ks[2], (DEPTH, D_MODEL)),
        'ffn_pre_g': gain(ks[3], (DEPTH, D_MODEL)),
        'ffn_post_g': gain(ks[4], (DEPTH, D_MODEL)),
        'ab_w_in': nrm(ks[5], (N_EVEN, D_MODEL, AB_IN), D_MODEL),
        'mla_q_norm_g': gain(ks[6], (N_EVEN, MLA_Q_LORA)),
        'mla_w_uq': nrm(ks[7], (N_EVEN, MLA_Q_LORA, MLA_HEADS * (MLA_NOPE + MLA_ROPE)), MLA_Q_LORA),
        'mla_kv_norm_g': gain(ks[8], (N_EVEN, MLA_KV_LORA)),
        'mla_w_ukv': nrm(ks[9], (N_EVEN, MLA_KV_LORA, MLA_HEADS * (MLA_NOPE + MLA_V)), MLA_KV_LORA),
        'ab_w_out': nrm(ks[10], (N_EVEN, AB_OUT, D_MODEL), AB_OUT),
        'rel_bias': 0.5 * jax.random.normal(ks[11], (NUM_BUCKETS, MOBA_HEADS), jnp.float32),
        'sb_w_qkv': nrm(ks[12], (N_ODD, D_MODEL, 3 * SB_WIDTH), D_MODEL),
        'sb_w_out': nrm(ks[13], (N_ODD, SB_WIDTH, D_MODEL), SB_WIDTH),
        'ffn_w_gate_up': nrm(ks[14], (DEPTH, D_MODEL, 2 * D_FF), D_MODEL),
        'ffn_w_down': nrm(ks[15], (DEPTH, D_FF, D_MODEL), D_FF),
    }


def reference(x, mix_pre_g, mix_post_g, ffn_pre_g, ffn_post_g, ab_w_in, mla_q_norm_g, mla_w_uq,
              mla_kv_norm_g, mla_w_ukv, ab_w_out, rel_bias, sb_w_qkv, sb_w_out, ffn_w_gate_up, ffn_w_down):
    B, S, _ = x.shape
    pos = jnp.arange(S)
    o1 = MLA_Q_LORA
    o2 = o1 + MLA_KV_LORA
    o3 = o2 + MLA_ROPE
    h = x
    for layer in range(DEPTH):
        u = rmsnorm(h, mix_pre_g[layer])
        if layer % 2 == 0:
            e = layer // 2
            proj = u @ ab_w_in[e]
            mla_out = mla_attention(proj[..., :o1], proj[..., o1:o2], proj[..., o2:o3],
                                    mla_q_norm_g[e], mla_w_uq[e], mla_kv_norm_g[e], mla_w_ukv[e], pos)
            qkv = proj[..., o3:].reshape(B, S, 3, MOBA_HEADS, HEAD_DIM).transpose(2, 0, 3, 1, 4)
            moba_out = moba_attention(qkv[0], qkv[1], qkv[2], rel_bias)
            mixed = jnp.concatenate([mla_out, moba_out], axis=-1) @ ab_w_out[e]
        else:
            o = layer // 2
            qkv = (u @ sb_w_qkv[o]).reshape(B, S, 3, SB_HEADS, HEAD_DIM).transpose(2, 0, 3, 1, 4)
            mixed = stick_breaking_attention(qkv[0], qkv[1], qkv[2]) @ sb_w_out[o]
        h = h + rmsnorm(mixed, mix_post_g[layer])
        u = rmsnorm(h, ffn_pre_g[layer])
        gu = u @ ffn_w_gate_up[layer]
        f = (jax.nn.silu(gu[..., :D_FF]) * gu[..., D_FF:]) @ ffn_w_down[layer]
        h = h + rmsnorm(f, ffn_post_g[layer])
    return h
```

```cpp
#include <hip/hip_runtime.h>
#include <cstdio>
#include <cstdint>
namespace pg8 {
#define PG8_LAS __attribute__((address_space(3)))
typedef unsigned short bf16_t;
typedef short bf16x8 __attribute__((ext_vector_type(8)));
typedef float f32x4 __attribute__((ext_vector_type(4)));
typedef unsigned u32x4 __attribute__((ext_vector_type(4)));
constexpr int BM = 256, BK = 64, HALF = 128, HTB = HALF * BK * 2  , STAGE_BYTES = 8 * HTB, NXCD = 8, WGM = 8;

__host__ __device__ __forceinline__ int lds_byte(int r, int c) { const int st = (r >> 4) * 2 + (c >> 5), rr = r & 15, cc = c & 31, ob = rr * 64 + cc * 2; return st * 1024 + (ob ^ (((ob >> 9) & 1) << 5)); }
__host__ __device__ __forceinline__ void stage_rc(int b, int& R, int& C) { const int st = b / 1024, sb = b % 1024, swz = sb ^ (((sb >> 9) & 1) << 5); R = (st >> 1) * 16 + swz / 64; C = (st & 1) * 32 + (swz % 64) / 2; }
__host__ __device__ __forceinline__ int perm32(int rho) { const int n = rho >> 4, i = rho & 15; return 8 * (i >> 2) + 4 * n + (i & 3); }

struct Unit { int pm, pn; };
struct Gemm { const bf16_t* A; const bf16_t* Bt; int M, N, K; };

struct StaticOrder {
    int nM, nN, nwg, G, c;
    __host__ __device__ void init(int M, int N, int G_, int c_) { nM = M / BM; nN = N / BM; nwg = nM * nN; G = G_; c = c_; }
    __host__ __device__ bool next(int i, Unit& u) const {
        const long L = (long)i * G + c; if (L >= nwg) return false;
        int wgid = (int)L; { const int q = nwg / NXCD, r = nwg % NXCD, xcd = wgid % NXCD, off = wgid / NXCD; wgid = (xcd < r ? xcd * (q + 1) : r * (q + 1) + (xcd - r) * q) + off; }
        const int nig = WGM * nN, gid = wgid / nig, fm = gid * WGM, gsz = (nM - fm) < WGM ? (nM - fm) : WGM;
        u.pm = fm + ((wgid % nig) % gsz); u.pn = (wgid % nig) / gsz; return true;
    }
    __device__ __forceinline__ void a_ready(const Unit&) const {}
    __device__ __forceinline__ void done(const Unit&) const {}
};

typedef float f32x2_t __attribute__((ext_vector_type(2))); typedef __bf16 bf16x2_t __attribute__((ext_vector_type(2)));
__device__ __forceinline__ unsigned cvt_pk_bf16(float lo, float hi) { f32x2_t v = {lo, hi}; bf16x2_t b = __builtin_convertvector(v, bf16x2_t); return __builtin_bit_cast(unsigned, b); }

struct EpiBf16 {
    static constexpr bool PERM = true, AFTER_DRAIN = false;
    bf16_t* O; int ldc; const float* rs;
    __device__ __forceinline__ void operator()(const f32x4 (&acc)[2][2][4][2], const Unit& u, int wr, int wc, int fr, int fq) const {
        const int row0 = u.pm * BM + wr * 64 + fr; const int col0 = u.pn * BM + wc * 32 + 8 * fq;
#pragma unroll
        for (int ai = 0; ai < 2; ++ai)
#pragma unroll
            for (int m = 0; m < 4; ++m) { bf16_t* rowp = O + (size_t)(row0 + ai * HALF + m * 16) * ldc + col0; const float sc = rs ? rs[row0 + ai * HALF + m * 16] : 1.f;
#pragma unroll
                for (int bj = 0; bj < 2; ++bj) { const f32x4 v0 = acc[ai][bj][m][0] * sc, v1 = acc[ai][bj][m][1] * sc;
                    u32x4 w; w.x = cvt_pk_bf16(v0[0], v0[1]); w.y = cvt_pk_bf16(v0[2], v0[3]); w.z = cvt_pk_bf16(v1[0], v1[1]); w.w = cvt_pk_bf16(v1[2], v1[3]);
                    *(u32x4*)(rowp + bj * HALF) = w; } }
    }
};
struct EpiSwiGLU {
    static constexpr bool PERM = true, AFTER_DRAIN = false;
    bf16_t* O; int ldc; const float* rs;
    __device__ __forceinline__ void operator()(const f32x4 (&acc)[2][2][4][2], const Unit& u, int wr, int wc, int fr, int fq) const {
        const int row0 = u.pm * BM + wr * 64 + fr; const int col0 = u.pn * HALF + wc * 32 + 8 * fq;
#pragma unroll
        for (int ai = 0; ai < 2; ++ai)
#pragma unroll
            for (int m = 0; m < 4; ++m) { bf16_t* rowp = O + (size_t)(row0 + ai * HALF + m * 16) * ldc + col0; const float sc = rs[row0 + ai * HALF + m * 16];
                float r[8];
#pragma unroll
                for (int n = 0; n < 2; ++n)
#pragma unroll
                    for (int j = 0; j < 4; ++j) { const float g = acc[ai][0][m][n][j] * sc, up = acc[ai][1][m][n][j] * sc;
                        const float s = __builtin_amdgcn_rcpf(1.0f + __builtin_amdgcn_exp2f(-1.4426950408889634f * g)); r[n * 4 + j] = g * s * up; }
                u32x4 w; w.x = cvt_pk_bf16(r[0], r[1]); w.y = cvt_pk_bf16(r[2], r[3]); w.z = cvt_pk_bf16(r[4], r[5]); w.w = cvt_pk_bf16(r[6], r[7]);
                *(u32x4*)rowp = w; }
    }
};

template <class Epi, class Sched, bool ALIGN_EPI = false, bool SP2 = false>
__device__ __forceinline__ void gemm_phase(PG8_LAS unsigned char* lds, const Gemm g, const Sched& S, const Epi& E, const int tid_in) {
    const int tid = tid_in, wid = __builtin_amdgcn_readfirstlane(tid >> 6), lane = tid & 63, wr = wid >> 2, wc = wid & 3, fr = lane & 15, fq = lane >> 4;
    const int K = g.K, nt = K / BK;
    unsigned voffA[2], voffB[2];
#pragma unroll
    for (int i = 0; i < 2; ++i) { int R, C; stage_rc(tid * 16 + i * 8192, R, C); const int Rb = Epi::PERM ? ((R & ~31) + perm32(R & 31)) : R;
        voffA[i] = (unsigned)(R * K + C) * 2u; voffB[i] = (unsigned)(Rb * K + C) * 2u; }
    const size_t kstep = (size_t)(BK * 2);
    const size_t hstep = (size_t)HALF * K * 2;
    const size_t tstep = 2 * hstep;
    const unsigned ldsw = (unsigned)wid * 1024u;
    const int aoff = lds_byte(wr * 64 + fr, fq * 8), boff = lds_byte(wc * 32 + fr, fq * 8);
#define PG8_SA(b, h) (((b) * 2 + (h)) * HTB)
#define PG8_SB(b, h) ((4 + (b) * 2 + (h)) * HTB)
#define PG8_STAGE(bufoff, gbase, voff) do { _Pragma("unroll") for (int _i = 0; _i < 2; ++_i) \
        __builtin_amdgcn_global_load_lds((const unsigned*)((const char*)(gbase) + (voff)[_i]), (PG8_LAS unsigned*)(lds + (bufoff) + ldsw + _i * 8192), 16, 0, 0); } while (0)
#define PG8_LDA(dst, b, h) do { _Pragma("unroll") for (int m = 0; m < 4; ++m) _Pragma("unroll") for (int k = 0; k < 2; ++k) dst[m][k] = *(const PG8_LAS bf16x8*)(lds + PG8_SA(b, h) + aoff + m * 2048 + k * 1024); } while (0)
#define PG8_LDB(dst, b, h) do { _Pragma("unroll") for (int n = 0; n < 2; ++n) _Pragma("unroll") for (int k = 0; k < 2; ++k) dst[n][k] = *(const PG8_LAS bf16x8*)(lds + PG8_SB(b, h) + boff + n * 2048 + k * 1024); } while (0)
#define PG8_MMA(ai, bj, At, Bt) do { __builtin_amdgcn_s_setprio(1); _Pragma("unroll") for (int m = 0; m < 4; ++m) _Pragma("unroll") for (int n = 0; n < 2; ++n) _Pragma("unroll") for (int k = 0; k < 2; ++k) \
        acc[ai][bj][m][n] = __builtin_amdgcn_mfma_f32_16x16x32_bf16(Bt[n][k], At[m][k], acc[ai][bj][m][n], 0, 0, 0); __builtin_amdgcn_s_setprio(0); } while (0)
#define PG8_WAIT_V(n) asm volatile("s_waitcnt vmcnt(" #n ")" ::: "memory")
#define PG8_WAIT_L(n) asm volatile("s_waitcnt lgkmcnt(" #n ")" ::: "memory")
#define PG8_BAR __builtin_amdgcn_s_barrier()
#define PG8_SCHED __builtin_amdgcn_sched_barrier(0)
    Unit cur, nxt; int ui = 0;
    if (!S.next(0, cur)) return;
    f32x4 acc[2][2][4][2];
#pragma unroll
    for (int a = 0; a < 2; ++a)
#pragma unroll
        for (int b = 0; b < 2; ++b)
#pragma unroll
            for (int m = 0; m < 4; ++m)
#pragma unroll
                for (int n = 0; n < 2; ++n) acc[a][b][m][n] = (f32x4){0.f, 0.f, 0.f, 0.f};
    bf16x8 At[4][2], B0[2][2], B1[2][2];
    const char* cA = (const char*)g.A + (size_t)cur.pm * tstep; const char* cB = (const char*)g.Bt + (size_t)cur.pn * tstep;
    S.a_ready(cur);
    if constexpr (SP2) {
        PG8_STAGE(PG8_SB(0, 0), cB, voffB); PG8_STAGE(PG8_SB(0, 1), cB + hstep, voffB); PG8_STAGE(PG8_SA(0, 0), cA, voffA); PG8_STAGE(PG8_SA(0, 1), cA + hstep, voffA);
        if (wr == 1) PG8_BAR;
        PG8_WAIT_V(2); PG8_BAR;
        PG8_STAGE(PG8_SB(1, 0), cB + kstep, voffB); PG8_STAGE(PG8_SA(1, 0), cA + kstep, voffA); PG8_STAGE(PG8_SB(1, 1), cB + hstep + kstep, voffB);
        PG8_WAIT_V(6); PG8_BAR;
    } else {
        PG8_STAGE(PG8_SB(0, 0), cB, voffB); PG8_STAGE(PG8_SA(0, 0), cA, voffA); PG8_STAGE(PG8_SB(0, 1), cB + hstep, voffB); PG8_STAGE(PG8_SA(0, 1), cA + hstep, voffA);
        if (wr == 1) PG8_BAR;
        PG8_WAIT_V(4); PG8_BAR;
        PG8_STAGE(PG8_SB(1, 0), cB + kstep, voffB); PG8_STAGE(PG8_SA(1, 0), cA + kstep, voffA); PG8_STAGE(PG8_SB(1, 1), cB + hstep + kstep, voffB);
        PG8_WAIT_V(6); PG8_BAR;
    }
    for (;;) {
        const bool has_next = S.next(ui + 1, nxt);
        const char* nA = has_next ? (const char*)g.A + (size_t)nxt.pm * tstep : cA; const char* nB = has_next ? (const char*)g.Bt + (size_t)nxt.pn * tstep : cB;
        for (int t = 0; t < nt; t += 2) {
            const bool last = (t == nt - 2);
            const char* a1 = cA + (size_t)(t + 1) * kstep;
            const char* a2 = last ? nA : cA + (size_t)(t + 2) * kstep; const char* b2 = last ? nB : cB + (size_t)(t + 2) * kstep;
            const char* a3 = a2 + kstep; const char* b3 = b2 + kstep;
            if (last && has_next) S.a_ready(nxt);
            if constexpr (SP2) {
            PG8_LDB(B0, 0, 0); PG8_LDB(B1, 0, 1); PG8_SCHED; PG8_LDA(At, 0, 0); PG8_STAGE(PG8_SA(1, 1), a1 + hstep, voffA);
            PG8_WAIT_V(8); PG8_WAIT_L(0); PG8_BAR; PG8_MMA(0, 0, At, B0); PG8_MMA(0, 1, At, B1); PG8_BAR; PG8_SCHED;
            PG8_LDA(At, 0, 1); PG8_STAGE(PG8_SB(0, 0), b2, voffB); PG8_STAGE(PG8_SB(0, 1), b2 + hstep, voffB); PG8_STAGE(PG8_SA(0, 0), a2, voffA);
            PG8_WAIT_V(8); PG8_WAIT_L(0); PG8_BAR; PG8_MMA(1, 0, At, B0); PG8_MMA(1, 1, At, B1); PG8_BAR; PG8_SCHED;
            PG8_LDB(B0, 1, 0); PG8_LDB(B1, 1, 1); PG8_SCHED; PG8_LDA(At, 1, 0); PG8_STAGE(PG8_SA(0, 1), a2 + hstep, voffA);
            PG8_WAIT_V(8); PG8_WAIT_L(0); PG8_BAR; PG8_MMA(0, 0, At, B0); PG8_MMA(0, 1, At, B1); PG8_BAR; PG8_SCHED;
            PG8_LDA(At, 1, 1); PG8_STAGE(PG8_SB(1, 0), b3, voffB); PG8_STAGE(PG8_SB(1, 1), b3 + hstep, voffB); PG8_STAGE(PG8_SA(1, 0), a3, voffA);
            PG8_WAIT_V(8); PG8_WAIT_L(0); PG8_BAR; PG8_MMA(1, 0, At, B0); PG8_MMA(1, 1, At, B1); PG8_BAR; PG8_SCHED;
            } else {
            PG8_LDB(B0, 0, 0); PG8_SCHED; PG8_LDA(At, 0, 0); PG8_STAGE(PG8_SA(1, 1), a1 + hstep, voffA);
            PG8_WAIT_L(8); PG8_BAR; PG8_WAIT_L(0); PG8_MMA(0, 0, At, B0); PG8_BAR; PG8_SCHED;
            PG8_LDB(B1, 0, 1); PG8_STAGE(PG8_SB(0, 0), b2, voffB);
            PG8_BAR; PG8_WAIT_L(0); PG8_MMA(0, 1, At, B1); PG8_BAR;
            PG8_LDA(At, 0, 1); PG8_STAGE(PG8_SA(0, 0), a2, voffA);
            PG8_BAR; PG8_WAIT_L(0); PG8_MMA(1, 0, At, B0); PG8_BAR; PG8_SCHED;
            PG8_STAGE(PG8_SB(0, 1), b2 + hstep, voffB);
            PG8_WAIT_V(6); PG8_BAR; PG8_MMA(1, 1, At, B1); PG8_BAR;
            PG8_LDB(B0, 1, 0); PG8_SCHED; PG8_LDA(At, 1, 0); PG8_STAGE(PG8_SA(0, 1), a2 + hstep, voffA);
            PG8_WAIT_L(8); PG8_BAR; PG8_WAIT_L(0); PG8_MMA(0, 0, At, B0); PG8_BAR; PG8_SCHED;
            PG8_LDB(B1, 1, 1); PG8_STAGE(PG8_SB(1, 0), b3, voffB);
            PG8_BAR; PG8_WAIT_L(0); PG8_MMA(0, 1, At, B1); PG8_BAR;
            PG8_LDA(At, 1, 1); PG8_STAGE(PG8_SA(1, 0), a3, voffA);
            PG8_BAR; PG8_WAIT_L(0); PG8_MMA(1, 0, At, B0); PG8_BAR; PG8_SCHED;
            PG8_STAGE(PG8_SB(1, 1), b3 + hstep, voffB);
            PG8_WAIT_V(6); PG8_BAR; PG8_MMA(1, 1, At, B1); PG8_BAR;
            }
        }
        if constexpr (ALIGN_EPI) { if (wr == 0) PG8_BAR; }
        if constexpr (!Epi::AFTER_DRAIN) { E(acc, cur, wr, wc, fr, fq); S.done(cur); }
        if (!has_next) break;
#pragma unroll
        for (int a = 0; a < 2; ++a)
#pragma unroll
            for (int b = 0; b < 2; ++b)
#pragma unroll
                for (int m = 0; m < 4; ++m)
#pragma unroll
                    for (int n = 0; n < 2; ++n) acc[a][b][m][n] = (f32x4){0.f, 0.f, 0.f, 0.f};
        cur = nxt; cA = nA; cB = nB; ++ui;
        if constexpr (ALIGN_EPI) { if (wr == 1) PG8_BAR; }
    }
    PG8_WAIT_V(0);
    if constexpr (!ALIGN_EPI) { if (wr == 0) PG8_BAR; }
    PG8_BAR;
    if constexpr (Epi::AFTER_DRAIN) { E.fused(acc, cur, wr, wc, fr, fq, lds, wid, lane); S.done(cur); }
#undef PG8_SA
#undef PG8_SB
#undef PG8_STAGE
#undef PG8_LDA
#undef PG8_LDB
#undef PG8_MMA
#undef PG8_WAIT_V
#undef PG8_WAIT_L
#undef PG8_BAR
#undef PG8_SCHED
}
}

#define GAS __attribute__((address_space(1)))
#define LAS __attribute__((address_space(3)))
typedef unsigned short bf16_t;
typedef unsigned u32x4 __attribute__((ext_vector_type(4)));
typedef unsigned u32x2 __attribute__((ext_vector_type(2)));
typedef float f32x4 __attribute__((ext_vector_type(4)));
typedef float f32x16 __attribute__((ext_vector_type(16)));
typedef short bf16x8 __attribute__((ext_vector_type(8)));
typedef short s16x4 __attribute__((ext_vector_type(4)));
typedef GAS unsigned gu32;
#define RLX_AGENT __ATOMIC_RELAXED, __HIP_MEMORY_SCOPE_AGENT
#define LDS_WAIT() asm volatile("s_waitcnt lgkmcnt(0)" ::: "memory")
#define VM_WAIT() asm volatile("s_waitcnt vmcnt(0)" ::: "memory")
using pg8::cvt_pk_bf16;
__device__ __forceinline__ float bf2f(unsigned short b) { return __uint_as_float(((unsigned)b) << 16); }
__device__ __forceinline__ float bflo(unsigned w) { return __uint_as_float(w << 16); }
__device__ __forceinline__ float bfhi(unsigned w) { return __uint_as_float(w & 0xffff0000u); }
__device__ __forceinline__ unsigned short f2bf(float f) { return (unsigned short)(cvt_pk_bf16(f, 0.f) & 0xffffu); }

#define XB_TMO      128
#define XB_XCNT(j)  (256  + 64 * (j))
#define XB_XSUB(j)  (1280 + 64 * (j))
#define XB_XGEN(j)  (2304 + 64 * (j))
#define XB_TOP      3328
#define XB_TOPGEN   3392
#define XCD_BAR_WORDS 3456
#define XB_SPIN_CAP (1u << 18)

__device__ __forceinline__ unsigned xb_ld(unsigned* p)              { return __hip_atomic_load(p, __ATOMIC_RELAXED, __HIP_MEMORY_SCOPE_AGENT); }
__device__ __forceinline__ unsigned xb_add(unsigned* p, unsigned v) { return __hip_atomic_fetch_add(p, v, __ATOMIC_RELAXED, __HIP_MEMORY_SCOPE_AGENT); }
__device__ __forceinline__ unsigned xb_xcc_id() { return (unsigned)__builtin_amdgcn_s_getreg((3 << 11) | 20) & 0xFu; }
#define XB_SPIN(cond, bar) do { unsigned _sp = 0; while (cond) { __builtin_amdgcn_s_sleep(1); \
    if ((++_sp & 255u) == 0u) { if (xb_ld(&(bar)[XB_TMO])) break; if (_sp > XB_SPIN_CAP) { atomicAdd(&(bar)[XB_TMO], 1u); break; } } } } while (0)

struct XcdBarrier {
    unsigned* bar; unsigned x;
    volatile LAS unsigned* st;
};

__device__ __forceinline__ XcdBarrier xcd_barrier_post(unsigned* bar, volatile LAS unsigned* st) {
    XcdBarrier b; b.bar = bar; b.x = xb_xcc_id(); b.st = st;
    if (threadIdx.x == 0) (void)xb_add(&bar[XB_XCNT(b.x)], 1u);
    return b;
}
__device__ __forceinline__ void xcd_barrier_complete(unsigned* bar, unsigned x, unsigned& nloc, unsigned& nx) {
    const unsigned G = gridDim.x * gridDim.y * gridDim.z;
    unsigned sum, cnt, mine, sp = 0u;
    for (;;) {
        sum = 0u; cnt = 0u; mine = 0u;
#pragma unroll
        for (unsigned j = 0; j < 16; ++j) { const unsigned c = xb_ld(&bar[XB_XCNT(j)]); sum += c; cnt += (c > 0u) ? 1u : 0u; mine = (j == x) ? c : mine; }
        if (sum == G) break;
        __builtin_amdgcn_s_sleep(1);
        if ((++sp & 255u) == 0u) { if (xb_ld(&bar[XB_TMO])) break; if (sp > XB_SPIN_CAP) { atomicAdd(&bar[XB_TMO], 1u); break; } }
    }
    nloc = mine > 0u ? mine : 1u; nx = cnt > 0u ? cnt : 1u;
}

__device__ __forceinline__ void xcd_barrier(const XcdBarrier& b) {
    asm volatile("s_waitcnt vmcnt(0)" ::: "memory");
    __syncthreads();
    if (threadIdx.x == 0) {
        unsigned* bar = b.bar;
        __builtin_amdgcn_s_waitcnt(0);
        unsigned nloc = b.st[0], nx = b.st[1];
        if (nloc == 0u) { xcd_barrier_complete(bar, b.x, nloc, nx); b.st[0] = nloc; b.st[1] = nx; }
        const unsigned old = xb_add(&bar[XB_XSUB(b.x)], 1u);
        const unsigned gen = old / nloc;
        if (old + 1u == (gen + 1u) * nloc) {
            __builtin_amdgcn_fence(__ATOMIC_RELEASE, "agent");
            asm volatile("s_waitcnt vmcnt(0)" ::: "memory");
            const unsigned og = xb_add(&bar[XB_TOP], 1u);
            const unsigned tg = og / nx;
            if (og + 1u == (tg + 1u) * nx) xb_add(&bar[XB_TOPGEN], 1u);
            else XB_SPIN(xb_ld(&bar[XB_TOPGEN]) == tg, bar);
            __builtin_amdgcn_fence(__ATOMIC_ACQUIRE, "agent");
            xb_add(&bar[XB_XGEN(b.x)], 1u);
            asm volatile("s_waitcnt vmcnt(0)" ::: "memory");
        } else {
            XB_SPIN(xb_ld(&bar[XB_XGEN(b.x)]) == gen, bar);
            __builtin_amdgcn_fence(__ATOMIC_ACQUIRE, "agent");
            asm volatile("s_waitcnt vmcnt(0)" ::: "memory");
        }
    }
    __syncthreads();
}

#ifndef MK_PER_PHASE
#define MK_PER_PHASE 0
#endif
#ifndef PROBE_DUP
#define PROBE_DUP 0
#endif
#define NREP(bit) ((PROBE_DUP >> (bit)) & 1 ? 2 : 1)
#ifndef PROBE_VAR
#define PROBE_VAR 0
#endif
constexpr int NWAVES = 8;
constexpr int BATCH = 16, SEQ = 2048, DM = 1024, M = BATCH * SEQ, DEPTH = 4, DFF = 2816;
constexpr int NPROJ = 4096, NQKV = 3072;
constexpr int PPROJ = 4160, PQKV = 3136;
constexpr int C_Q = 0, C_KN = 768, C_V = 1280, C_KR = 1792, C_CQ = 1824, C_CKV = 2208, C_PAD = 2464, C_MQ = 2560, C_MK = 3072, C_MV = 3584;
constexpr float RMS_EPS = 1e-6f, LOG2E = 1.4426950408889634f;
constexpr float SC_MLA = 0.10206207261596575f * LOG2E, SC_64 = 0.125f * LOG2E;

constexpr size_t MiB = 1u << 20;
constexpr size_t WS_CTL = 0, CTL_ZERO_BYTES = 1 * MiB;
constexpr size_t WS_ROPE = 1 * MiB;
constexpr size_t WS_KBP = 2 * MiB;
constexpr size_t WS_RSX = 3 * MiB, WS_RSY = 3 * MiB + 512 * 1024;
constexpr size_t WS_WCAT = 4 * MiB, WS_WOAB = 20 * MiB, WS_WQKV = 24 * MiB, WS_WOSB = 36 * MiB, WS_WGU = 40 * MiB, WS_WDN = 84 * MiB;
constexpr size_t SZ_WCAT = 8 * MiB, SZ_WO = 2 * MiB, SZ_WQKV = 6 * MiB, SZ_WGU = 11 * MiB, SZ_WDN = 5632 * 1024;
constexpr size_t WS_XN = 106 * MiB, WS_ATT = 170 * MiB, WS_BIG = 234 * MiB, WS_END = 496 * MiB;
static_assert(WS_WDN + 4 * SZ_WDN <= WS_XN && WS_BIG + (size_t)M * PPROJ * 2 <= WS_END, "d_ws map");
constexpr int CW_TMO = 0, CW_BAR = 4096, CW_Q = 8192;
constexpr int RING_BYTES = 131072, LDSCTL_OFF = RING_BYTES, MISC_OFF = LDSCTL_OFF + 320, LDS_BYTES = 147456;
constexpr int N_PHASES = 31;

__device__ __forceinline__ int launder(int v) { asm volatile("" : "+v"(v)); return v; }
__device__ __forceinline__ int fresh_tid(int wave_s) { unsigned z = 0u; asm volatile("" : "+v"(z)); return wave_s * 64 + (int)__builtin_amdgcn_mbcnt_hi(~0u, __builtin_amdgcn_mbcnt_lo(~0u, z)); }
__device__ __forceinline__ float wave_sum(float v) {
#pragma unroll
    for (int o = 1; o < 64; o <<= 1) v += __shfl_xor(v, o);
    return v;
}

struct TrDesc { const float* W; bf16_t* WT; const float* gk; int N, K, kb, n0, dst; float sc; };
__device__ __forceinline__ void p0_tr_load(const TrDesc& d, float (&tv)[32], int lane) {
    const int k0 = 64 * d.kb;
#pragma unroll
    for (int i = 0; i < 32; ++i) tv[i] = *(const GAS float*)(d.W + (size_t)(k0 + 2 * i + (lane >> 5)) * d.N + d.n0 + (lane & 31));
}
__device__ __forceinline__ void p0_tr_process(const TrDesc& d, const float (&tv)[32], LAS float* scr, int lane) {
    const int k0 = 64 * d.kb;
#pragma unroll
    for (int i = 0; i < 32; ++i) scr[(2 * i + (lane >> 5)) * 33 + (lane & 31)] = tv[i];
    LDS_WAIT(); asm volatile("" ::: "memory");
    const int c = lane & 7; float gs[8];
#pragma unroll
    for (int q = 0; q < 8; ++q) gs[q] = d.gk ? d.gk[k0 + 8 * c + q] * d.sc : d.sc;
#pragma unroll
    for (int j = 0; j < 4; ++j) { const int n = (lane >> 3) + 8 * j; const LAS float* s = scr + (8 * c) * 33 + n;
        u32x4 o; o.x = cvt_pk_bf16(s[0 * 33] * gs[0], s[1 * 33] * gs[1]); o.y = cvt_pk_bf16(s[2 * 33] * gs[2], s[3 * 33] * gs[3]);
        o.z = cvt_pk_bf16(s[4 * 33] * gs[4], s[5 * 33] * gs[5]); o.w = cvt_pk_bf16(s[6 * 33] * gs[6], s[7 * 33] * gs[7]);
        *(GAS u32x4*)(d.WT + (size_t)(d.dst + n) * d.K + k0 + 8 * c) = o; }
    LDS_WAIT(); asm volatile("" ::: "memory");
}
__device__ __forceinline__ void map_group(int mat, int n0, int& dst, float& sc) {
    sc = 1.f; dst = n0;
    if (mat == 0) { if (n0 < 384) dst = C_CQ + n0; else if (n0 < 640) dst = C_CKV + (n0 - 384); else if (n0 < 672) dst = C_KR + (n0 - 640); else { dst = C_MQ + (n0 - 672); if (n0 < 1184) sc = SC_64; } }
    else if (mat == 2) { if (n0 < 1024) sc = SC_64; }
    else if (mat == 4) { if (n0 < DFF) dst = 256 * (n0 >> 7) + (n0 & 127); else { const int n1 = n0 - DFF; dst = 256 * (n1 >> 7) + 128 + (n1 & 127); } }
}
__device__ __forceinline__ void p0_fuse_item(const float* Win, int roff, int R, const float* Wu, int NU, const float* g, const float* gpre  , bf16_t* WT, int nt, int kt, bool is_kv, float sc, LAS float* su, LAS float* si, int tid) {
    const int tn = tid & 63, tk = tid >> 6; float acc[8];
#pragma unroll
    for (int j = 0; j < 8; ++j) acc[j] = 0.f;
    for (int r0 = 0; r0 < R; r0 += 32) {
        __syncthreads();
#pragma unroll
        for (int i = 0; i < 4; ++i) { const int rr = (tid >> 6) + 8 * i; su[rr * 64 + tn] = Wu[(size_t)(r0 + rr) * NU + nt * 64 + tn] * g[r0 + rr]; }
#pragma unroll
        for (int i = 0; i < 4; ++i) { const int k = (tid >> 5) + 16 * i, rr = tid & 31; si[k * 36 + rr] = Win[(size_t)(kt * 64 + k) * 2208 + roff + r0 + rr]; }
        __syncthreads();
#pragma unroll 2
        for (int r4 = 0; r4 < 32; r4 += 4) {
            const float a0 = su[(r4 + 0) * 64 + tn], a1 = su[(r4 + 1) * 64 + tn], a2 = su[(r4 + 2) * 64 + tn], a3 = su[(r4 + 3) * 64 + tn];
#pragma unroll
            for (int j = 0; j < 8; ++j) { const f32x4 b = *(const LAS f32x4*)(si + (tk * 8 + j) * 36 + r4); acc[j] += a0 * b.x + a1 * b.y + a2 * b.z + a3 * b.w; }
        }
    }
    const int n = nt * 64 + tn;
    const int dst = is_kv ? (((n & 127) < 64) ? C_KN + (n >> 7) * 64 + (n & 127) : C_V + (n >> 7) * 64 + (n & 127) - 64) : n;
#pragma unroll
    for (int j = 0; j < 8; ++j) acc[j] *= sc * gpre[kt * 64 + tk * 8 + j];
    u32x4 o; o.x = cvt_pk_bf16(acc[0], acc[1]); o.y = cvt_pk_bf16(acc[2], acc[3]); o.z = cvt_pk_bf16(acc[4], acc[5]); o.w = cvt_pk_bf16(acc[6], acc[7]);
    *(GAS u32x4*)(WT + (size_t)dst * 1024 + kt * 64 + tk * 8) = o;
}
__device__ __forceinline__ void x_row_to_bf16(const float* xrow, bf16_t* orow, float* rs, int lane) {
    f32x4 v[4]; float s = 0.f;
#pragma unroll
    for (int j = 0; j < 4; ++j) { v[j] = ((const GAS f32x4*)xrow)[lane + 64 * j]; s += (v[j].x * v[j].x + v[j].y * v[j].y) + (v[j].z * v[j].z + v[j].w * v[j].w); }
    const float r = __builtin_amdgcn_rsqf(wave_sum(s) * (1.f / DM) + RMS_EPS);
    if (lane == 0) *rs = r;
#pragma unroll
    for (int j = 0; j < 4; ++j) { u32x2 w; w.x = cvt_pk_bf16(v[j].x, v[j].y); w.y = cvt_pk_bf16(v[j].z, v[j].w); ((GAS u32x2*)orow)[lane + 64 * j] = w; }
}
template <bool HOUT16> __device__ __forceinline__ void resnorm_one(const u32x2 (&hw)[4], const u32x2 (&dw)[4], const f32x4 (&gg)[4], void* hout_, float* rs, int lane) {
    float s = 0.f;
#pragma unroll
    for (int j = 0; j < 4; ++j) { const float a = bflo(dw[j].x), b = bfhi(dw[j].x), c = bflo(dw[j].y), d = bfhi(dw[j].y); s += (a * a + b * b) + (c * c + d * d); }
    const float rd = __builtin_amdgcn_rsqf(wave_sum(s) * (1.f / DM) + RMS_EPS); float s2 = 0.f;
#pragma unroll
    for (int j = 0; j < 4; ++j) { const f32x4 dv = (f32x4){bflo(dw[j].x), bfhi(dw[j].x), bflo(dw[j].y), bfhi(dw[j].y)};
        const f32x4 hv = (f32x4){bflo(hw[j].x), bfhi(hw[j].x), bflo(hw[j].y), bfhi(hw[j].y)} + dv * rd * gg[j];
        if (HOUT16) { u32x2 w; w.x = cvt_pk_bf16(hv.x, hv.y); w.y = cvt_pk_bf16(hv.z, hv.w); ((GAS u32x2*)hout_)[lane + 64 * j] = w; }
        else ((GAS f32x4*)hout_)[lane + 64 * j] = hv;
        s2 += (hv.x * hv.x + hv.y * hv.y) + (hv.z * hv.z + hv.w * hv.w); }
    if (rs) { const float r2 = __builtin_amdgcn_rsqf(wave_sum(s2) * (1.f / DM) + RMS_EPS); if (lane == 0) *rs = r2; }
}
template <bool HOUT16> __device__ __forceinline__ void resnorm_phase(const bf16_t* hin, const bf16_t* D, const float* gp, void* hout, float* rs, int gw, int NGW, int lane) {
    const size_t ob = HOUT16 ? 2 : 4;
    f32x4 gg[4];
#pragma unroll
    for (int j = 0; j < 4; ++j) gg[j] = ((const GAS f32x4*)gp)[lane + 64 * j];
    if (NGW * 16 == M) {
        constexpr int DEPTH_ = 6; u32x2 hw[DEPTH_][4], dw[DEPTH_][4];
#define RN_LOAD(k_) do { const size_t mm = (size_t)(gw + (k_) * NGW) * DM; _Pragma("unroll") for (int j = 0; j < 4; ++j) { hw[(k_) % DEPTH_][j] = ((const GAS u32x2*)(hin + mm))[lane + 64 * j]; dw[(k_) % DEPTH_][j] = ((const GAS u32x2*)(D + mm))[lane + 64 * j]; } } while (0)
#pragma unroll
        for (int k = 0; k < DEPTH_; ++k) RN_LOAD(k);
#pragma unroll
        for (int k = 0; k < 16; ++k) { const size_t m = (size_t)(gw + k * NGW);
            resnorm_one<HOUT16>(hw[k % DEPTH_], dw[k % DEPTH_], gg, (char*)hout + m * DM * ob, rs ? rs + m : nullptr, lane);
            if (k + DEPTH_ < 16) RN_LOAD(k + DEPTH_); }
#undef RN_LOAD
    } else {
        for (int m = gw; m < M; m += NGW) { u32x2 hw[4], dw[4];
#pragma unroll
            for (int j = 0; j < 4; ++j) { hw[j] = ((const GAS u32x2*)(hin + (size_t)m * DM))[lane + 64 * j]; dw[j] = ((const GAS u32x2*)(D + (size_t)m * DM))[lane + 64 * j]; }
            resnorm_one<HOUT16>(hw, dw, gg, (char*)hout + (size_t)m * DM * ob, rs ? rs + m : nullptr, lane); }
    }
}
__device__ __forceinline__ float ssq8(const u32x4 w) { float s = 0.f; const unsigned a[4] = {w.x, w.y, w.z, w.w};
#pragma unroll
    for (int i = 0; i < 4; ++i) { const float lo = bflo(a[i]), hi = bfhi(a[i]); s += lo * lo + hi * hi; } return s; }
__device__ __forceinline__ u32x4 scale8(const u32x4 w, float s) { u32x4 o; o.x = cvt_pk_bf16(bflo(w.x) * s, bfhi(w.x) * s); o.y = cvt_pk_bf16(bflo(w.y) * s, bfhi(w.y) * s);
    o.z = cvt_pk_bf16(bflo(w.z) * s, bfhi(w.z) * s); o.w = cvt_pk_bf16(bflo(w.w) * s, bfhi(w.w) * s); return o; }
template <int R> __device__ __forceinline__ void prep_rows(bf16_t* P0, size_t rstride  , const float* cs0, const int (&pos)[R], int lane) {
    u32x4 wq[R], wk[R], qn[R], kn[R], vv[R], x1[R], x2[R]; f32x4 ct[R][4];
    const int o = lane & 1; const bool isq = lane < 16;
#pragma unroll
    for (int r = 0; r < R; ++r) { bf16_t* P = P0 + r * rstride;
        wq[r] = (u32x4){0u, 0u, 0u, 0u}; wk[r] = wq[r]; x1[r] = wq[r]; x2[r] = wq[r];
        if (lane < 48) wq[r] = *(const GAS u32x4*)(P + C_CQ + lane * 8);
        if (lane < 32) wk[r] = *(const GAS u32x4*)(P + C_CKV + lane * 8);
        qn[r] = *(const GAS u32x4*)(P + C_Q + (lane >> 3) * 96 + (lane & 7) * 8);
        kn[r] = *(const GAS u32x4*)(P + C_KN + lane * 8);
        vv[r] = *(const GAS u32x4*)(P + C_V + lane * 8);
        if (lane < 18) { const bf16_t* a1 = isq ? P + C_Q + (lane >> 1) * 96 + 64 + o * 8 : P + C_KR + o * 8; x1[r] = *(const GAS u32x4*)a1; x2[r] = *(const GAS u32x4*)(a1 + 16);
#pragma unroll
            for (int i = 0; i < 4; ++i) ct[r][i] = *(const GAS f32x4*)(cs0 + (size_t)pos[r] * 32 + (o * 8 + 2 * i) * 2); }
    }
    float sq[R], sk[R];
#pragma unroll
    for (int r = 0; r < R; ++r) { sq[r] = ssq8(wq[r]); sk[r] = ssq8(wk[r]); }
#pragma unroll
    for (int off = 1; off < 64; off <<= 1)
#pragma unroll
        for (int r = 0; r < R; ++r) { sq[r] += __shfl_xor(sq[r], off); sk[r] += __shfl_xor(sk[r], off); }
#pragma unroll
    for (int r = 0; r < R; ++r) { bf16_t* P = P0 + r * rstride;
        const float rq = __builtin_amdgcn_rsqf(sq[r] * (1.f / 384.f) + RMS_EPS), rkv = __builtin_amdgcn_rsqf(sk[r] * (1.f / 256.f) + RMS_EPS);
        *(GAS u32x4*)(P + C_Q + (lane >> 3) * 96 + (lane & 7) * 8) = scale8(qn[r], rq);
        *(GAS u32x4*)(P + C_KN + lane * 8) = scale8(kn[r], rkv);
        *(GAS u32x4*)(P + C_V + lane * 8) = scale8(vv[r], rkv);
        if (lane < 18) {
            const float sc = isq ? rq : 1.f; bf16_t* a1 = isq ? P + C_Q + (lane >> 1) * 96 + 64 + o * 8 : P + C_KR + o * 8;
            const unsigned y1[4] = {x1[r].x, x1[r].y, x1[r].z, x1[r].w}, y2[4] = {x2[r].x, x2[r].y, x2[r].z, x2[r].w}; unsigned o1[4], o2[4];
#pragma unroll
            for (int i = 0; i < 4; ++i) { const f32x4 c = ct[r][i];
                const float a = bflo(y1[i]) * sc, b = bflo(y2[i]) * sc, a_ = bfhi(y1[i]) * sc, b_ = bfhi(y2[i]) * sc;
                o1[i] = cvt_pk_bf16(a * c.x - b * c.y, a_ * c.z - b_ * c.w); o2[i] = cvt_pk_bf16(a * c.y + b * c.x, a_ * c.w + b_ * c.z); }
            *(GAS u32x4*)a1 = (u32x4){o1[0], o1[1], o1[2], o1[3]}; *(GAS u32x4*)(a1 + 16) = (u32x4){o2[0], o2[1], o2[2], o2[3]};
        }
    }
}

namespace att {
typedef short v4i16_t __attribute__((ext_vector_type(4)));
constexpr int VS = 192, KBUF = 64 * 208, VBUF = 64 * VS;
constexpr int OFF_K = 0, OFF_V = 2 * KBUF, OFF_FLAG = LDSCTL_OFF + 1024, OFF_WORK = OFF_FLAG + 128, OFF_BIAS = OFF_V + 3 * VBUF + 128, OFF_KBH = OFF_BIAS + 8 * 128 * 4, KB_STR = 144, OFF_KBL = OFF_KBH + 8 * KB_STR, OFF_END = OFF_KBL + 8 * KB_STR;
static_assert(OFF_END <= RING_BYTES && (OFF_BIAS % 16) == 0 && (OFF_KBH % 16) == 0 && (OFF_KBL % 16) == 0, "attention LDS map");
struct Tens { const bf16_t* Q; const bf16_t* K1; const bf16_t* K2; const bf16_t* V; bf16_t* O; int pitch, opitch; };
#define MFMA32(a, b, c) __builtin_amdgcn_mfma_f32_32x32x16_bf16((a), (b), (c), 0, 0, 0)
__device__ __forceinline__ int crow(int i, int h) { return (i & 3) + 8 * (i >> 2) + 4 * h; }
__device__ __forceinline__ s16x4 vtr(const LAS unsigned char* p) { return __builtin_bit_cast(s16x4, __builtin_amdgcn_ds_read_tr16_b64_v4i16((LAS v4i16_t*)p)); }
__device__ __forceinline__ bf16x8 pack8(const f32x16& x, int s) { u32x4 p; p.x = cvt_pk_bf16(x[8 * s], x[8 * s + 1]); p.y = cvt_pk_bf16(x[8 * s + 2], x[8 * s + 3]); p.z = cvt_pk_bf16(x[8 * s + 4], x[8 * s + 5]); p.w = cvt_pk_bf16(x[8 * s + 6], x[8 * s + 7]); return __builtin_bit_cast(bf16x8, p); }

template <int DK> __device__ __forceinline__ void stage_load(u32x4& rk1, u32x4& rk2, u32x4& rv, const Tens& T, int s0, int tid) {
    const int row = tid >> 3, ch = tid & 7;
    rk1 = *(const GAS u32x4*)(T.K1 + (size_t)(s0 + row) * T.pitch + ch * 8);
    rv = *(const GAS u32x4*)(T.V + (size_t)(s0 + row) * T.pitch + ch * 8);
    if (DK == 96) { if (tid < 256) rk2 = *(const GAS u32x4*)(T.K2 + (size_t)(s0 + (tid >> 2)) * T.pitch + (tid & 3) * 8); }
}
template <int DK> __device__ __forceinline__ void stage_store(LAS unsigned char* lds, int kslot, int vslot, const u32x4& rk1, const u32x4& rk2, const u32x4& rv, int tid) {
    constexpr int KSTR = DK * 2 + 16;
    *(LAS u32x4*)(lds + OFF_K + kslot * KBUF + (tid >> 3) * KSTR + (tid & 7) * 16) = rk1;
    *(LAS u32x4*)(lds + OFF_V + vslot * VBUF + (tid >> 3) * VS + (tid & 7) * 16) = rv;
    if (DK == 96) { if (tid < 256) *(LAS u32x4*)(lds + OFF_K + kslot * KBUF + (tid >> 2) * KSTR + 128 + (tid & 3) * 16) = rk2; }
}
template <int DK> __device__ __forceinline__ void qk(f32x16& p0, f32x16& p1, const LAS unsigned char* Kb, const bf16x8* qf, int r, int h, const f32x16& init) {
    constexpr int KSTR = DK * 2 + 16;
    p0 = init; p1 = init;
#pragma unroll
    for (int ks = 0; ks < DK / 16; ++ks) {
        const bf16x8 a0 = *(const LAS bf16x8*)(Kb + r * KSTR + ks * 32 + h * 16);
        const bf16x8 a1 = *(const LAS bf16x8*)(Kb + (32 + r) * KSTR + ks * 32 + h * 16);
        p0 = MFMA32(a0, qf[ks], p0); p1 = MFMA32(a1, qf[ks], p1);
    }
}
__device__ __forceinline__ void pv(f32x16 (&o)[2], const f32x16& p0, const f32x16& p1, const LAS unsigned char* Vb, int lane) {
    const int h = lane >> 5, blk = (lane >> 4) & 1, q = (lane & 15) >> 2, pp = lane & 3;
    const LAS unsigned char* vb = Vb + (4 * h + q) * VS + blk * 32 + pp * 8;
#pragma unroll
    for (int kb = 0; kb < 2; ++kb)
#pragma unroll
        for (int s = 0; s < 2; ++s) {
            const bf16x8 xs = pack8(kb ? p1 : p0, s);
#pragma unroll
            for (int db = 0; db < 2; ++db) {
                const s16x4 lo = vtr(vb + (kb * 32 + 16 * s) * VS + db * 64), hi = vtr(vb + (kb * 32 + 16 * s + 8) * VS + db * 64);
                const bf16x8 vf = __builtin_shufflevector(lo, hi, 0, 1, 2, 3, 4, 5, 6, 7);
                o[db] = MFMA32(vf, xs, o[db]);
            }
        }
}
struct VFrags { s16x4 lo[8], hi[8]; };
template <int DK> __device__ __forceinline__ void load_kfrags(bf16x8 (&kf)[2 * (DK / 16)], const LAS unsigned char* Kb, int r, int h) {
    constexpr int KSTR = DK * 2 + 16;
#pragma unroll
    for (int ks = 0; ks < DK / 16; ++ks) { kf[2 * ks] = *(const LAS bf16x8*)(Kb + r * KSTR + ks * 32 + h * 16); kf[2 * ks + 1] = *(const LAS bf16x8*)(Kb + (32 + r) * KSTR + ks * 32 + h * 16); }
    __builtin_amdgcn_sched_barrier(0);
}
__device__ __forceinline__ void load_vfrags(VFrags& vf, const LAS unsigned char* Vb, int lane) {
    const int h = lane >> 5, blk = (lane >> 4) & 1, q = (lane & 15) >> 2, pp = lane & 3;
    const LAS unsigned char* vb = Vb + (4 * h + q) * VS + blk * 32 + pp * 8;
#pragma unroll
    for (int kb = 0; kb < 2; ++kb)
#pragma unroll
        for (int s = 0; s < 2; ++s)
#pragma unroll
            for (int db = 0; db < 2; ++db) { vf.lo[(kb * 2 + s) * 2 + db] = vtr(vb + (kb * 32 + 16 * s) * VS + db * 64); vf.hi[(kb * 2 + s) * 2 + db] = vtr(vb + (kb * 32 + 16 * s + 8) * VS + db * 64); }
    __builtin_amdgcn_sched_barrier(0);
}
template <int DK> __device__ __forceinline__ void qk_pre(f32x16& p0, f32x16& p1, const bf16x8 (&kf)[2 * (DK / 16)], const bf16x8* qf, const f32x16& init) {
    p0 = init; p1 = init;
#pragma unroll
    for (int ks = 0; ks < DK / 16; ++ks) { p0 = MFMA32(kf[2 * ks], qf[ks], p0); p1 = MFMA32(kf[2 * ks + 1], qf[ks], p1); }
}
__device__ __forceinline__ void pv_pre(f32x16 (&o)[2], const f32x16& p0, const f32x16& p1, const VFrags& vf) {
#pragma unroll
    for (int kb = 0; kb < 2; ++kb)
#pragma unroll
        for (int s = 0; s < 2; ++s) {
            const bf16x8 xs = pack8(kb ? p1 : p0, s);
#pragma unroll
            for (int db = 0; db < 2; ++db) { const bf16x8 v = __builtin_shufflevector(vf.lo[(kb * 2 + s) * 2 + db], vf.hi[(kb * 2 + s) * 2 + db], 0, 1, 2, 3, 4, 5, 6, 7); o[db] = MFMA32(v, xs, o[db]); }
        }
}
__device__ __forceinline__ float rowmax32(const f32x16& p0, const f32x16& p1) {
    float a = fmaxf(p0[0], p1[0]);
#pragma unroll
    for (int i = 1; i < 16; ++i) a = fmaxf(a, fmaxf(p0[i], p1[i]));
    auto rr = __builtin_amdgcn_permlane32_swap(__float_as_uint(a), __float_as_uint(a), false, false);
    return fmaxf(__uint_as_float(rr[0]), __uint_as_float(rr[1]));
}
__device__ __forceinline__ void sm_step(bool first, f32x16& p0, f32x16& p1, float& m, float& l, f32x16& negm, f32x16 (&o)[2]) {
    const float mx = rowmax32(p0, p1);
    if (first || __any(mx > 8.0f ? 1 : 0)) {
        asm volatile("" ::: "memory");
        const float d = first ? mx : fmaxf(mx, 0.f), a = first ? 0.f : __builtin_amdgcn_exp2f(-d); m += d; l *= a;
#pragma unroll
        for (int i = 0; i < 16; ++i) { p0[i] -= d; p1[i] -= d; o[0][i] *= a; o[1][i] *= a; negm[i] = -m; }
    }
    float ps = 0.f;
#pragma unroll
    for (int i = 0; i < 16; ++i) { p0[i] = __builtin_amdgcn_exp2f(p0[i]); p1[i] = __builtin_amdgcn_exp2f(p1[i]); ps += p0[i] + p1[i]; }
    l += ps;
}
__device__ __forceinline__ void store_o(const f32x16 (&o)[2], float inv, bf16_t* orow, int h) {
#pragma unroll
    for (int db = 0; db < 2; ++db)
#pragma unroll
        for (int g = 0; g < 4; ++g) { u32x2 w; w.x = cvt_pk_bf16(o[db][4 * g] * inv, o[db][4 * g + 1] * inv); w.y = cvt_pk_bf16(o[db][4 * g + 2] * inv, o[db][4 * g + 3] * inv);
            *(GAS u32x2*)(orow + db * 32 + 8 * g + 4 * h) = w; }
}
__device__ __forceinline__ f32x16 splat16(float v) { f32x16 x;
#pragma unroll
    for (int i = 0; i < 16; ++i) x[i] = v; return x; }

template <int VAR> __device__ __forceinline__ void att_smpv(bool first, const LAS unsigned char* Vb, int lane, f32x16& p0, f32x16& p1, float& m, float& l, f32x16& negm, f32x16 (&o)[2]) {
    VFrags vf; load_vfrags(vf, Vb, lane);
    if (VAR != 3) sm_step(first, p0, p1, m, l, negm, o);
    if (VAR != 4) pv_pre(o, p0, p1, vf); else { o[0][0] += p0[3] + (float)vf.lo[0][0] + (float)vf.hi[7][1]; }
}
template <int VAR> __device__ __forceinline__ void mla_qk(bool mask, const LAS unsigned char* Kb, const bf16x8* qf, int s0, int qidx, int r, int h, const f32x16& negm, f32x16& p0, f32x16& p1) {
    bf16x8 kf[12];
    load_kfrags<96>(kf, Kb, r, h);
    if (VAR != 4) qk_pre<96>(p0, p1, kf, qf, negm); else { p0 = negm; p1 = negm; p0[0] += (float)kf[0][0] + (float)kf[11][7]; p1[1] += (float)kf[5][3]; }
    if (mask) {
        asm volatile("" ::: "memory");
#pragma unroll
        for (int i = 0; i < 16; ++i) { const int kv = s0 + crow(i, h); if (kv > qidx) p0[i] = -INFINITY; if (kv + 32 > qidx) p1[i] = -INFINITY; }
    }
}
template <int VAR> __device__ __forceinline__ void mla_unit(LAS unsigned char* lds, const Tens& T, int qb, int tid, int wid, int lane) {
    const int r = lane & 31, h = lane >> 5, q0 = qb * 256, q0w = q0 + wid * 32, qidx = q0w + r;
    bf16x8 qf[6];
#pragma unroll
    for (int ks = 0; ks < 6; ++ks) qf[ks] = *(const GAS bf16x8*)(T.Q + (size_t)qidx * T.pitch + ks * 16 + h * 8);
    f32x16 o[2]; o[0] = splat16(0.f); o[1] = splat16(0.f); f32x16 negm = splat16(0.f); float m = 0.f, l = 0.f;
    const int NT = (q0 + 256) / 64, wtop = (q0w + 31) / 64;
    u32x4 rk1, rk2, rv; rk2 = (u32x4){0u, 0u, 0u, 0u};
    stage_load<96>(rk1, rk2, rv, T, 0, tid); stage_store<96>(lds, 0, 0, rk1, rk2, rv, tid);
    stage_load<96>(rk1, rk2, rv, T, 64, tid);
    __syncthreads();
    int cur = 0, vcur = 0, vnext = 1, vfree = 2;
    f32x16 p0 = splat16(0.f), p1 = splat16(0.f); const bool lead = wid < 4;
#define MLA_SYNC(t_) do { if (VAR != 2) { if ((t_) + 1 < NT) stage_store<96>(lds, cur ^ 1, vnext, rk1, rk2, rv, tid); if ((t_) + 2 < NT) stage_load<96>(rk1, rk2, rv, T, ((t_) + 2) * 64, tid); } __syncthreads(); } while (0)
    for (int t = 0; t < NT; ++t) {
        const bool act = (VAR != 1) && t <= wtop;
        if (act) mla_qk<VAR>(t == wtop, lds + OFF_K + cur * KBUF, qf, t * 64, qidx, r, h, negm, p0, p1);
        if (!lead) MLA_SYNC(t);
        if (act) att_smpv<VAR>(t == 0, lds + OFF_V + vcur * VBUF, lane, p0, p1, m, l, negm, o);
        if (lead) MLA_SYNC(t);
        cur ^= 1; { const int tmp = vcur; vcur = vnext; vnext = vfree; vfree = tmp; }
    }
#undef MLA_SYNC
    l += __shfl_xor(l, 32);
    store_o(o, 1.0f / l, T.O + (size_t)qidx * T.opitch, h);
    __syncthreads();
}

template <int VAR> __device__ __forceinline__ void moba_qk(bool mask, bool lookup, const LAS unsigned char* Kb, const bf16x8* qf, const LAS float* btab, float b31, int s0, int qidx, bool rowsel,
                                        int r, int h, const f32x16& negm, f32x16& p0, f32x16& p1) {
    f32x16 c; const float cb = lookup ? 0.f : b31; bf16x8 kf[8];
    load_kfrags<64>(kf, Kb, r, h);
#pragma unroll
    for (int i = 0; i < 16; ++i) c[i] = negm[i] + cb;
    if (VAR != 4) qk_pre<64>(p0, p1, kf, qf, c); else { p0 = c; p1 = c; p0[0] += (float)kf[0][0] + (float)kf[7][7]; p1[1] += (float)kf[5][3]; }
    if (lookup) {
        asm volatile("" ::: "memory");
#pragma unroll
        for (int j = 0; j < 16; ++j) { const int rel = qidx - (s0 + crow(j, h)); const int r0 = min(max(rel, 0), 127), r1 = min(max(rel - 32, 0), 127); p0[j] += btab[r0]; p1[j] += btab[r1]; }
    }
    if (mask) {
        asm volatile("" ::: "memory");
#pragma unroll
        for (int j = 0; j < 16; ++j) { const int kv = s0 + crow(j, h); if (kv > qidx) p0[j] = -INFINITY; if (kv + 32 > qidx) p1[j] = -INFINITY; }
    }
    if (!__all(rowsel ? 1 : 0)) { asm volatile("" ::: "memory"); if (!rowsel) { p0 = splat16(-INFINITY); p1 = splat16(-INFINITY); } }
}
template <int VAR> __device__ __forceinline__ void moba_unit(LAS unsigned char* lds, const Tens& T, const float* kbp  , const LAS float* btab  ,
                                          int qb, int tid, int wid, int lane) {
    const int r = lane & 31, h = lane >> 5, own = qb, q0 = qb * 256, q0w = q0 + wid * 32, qidx = q0w + r;
    {
        const int n = tid >> 6, d = tid & 63; float s = 0.f;
        if (n < own) {
#pragma unroll
            for (int q4 = 0; q4 < 4; ++q4) s += kbp[(size_t)(n * 4 + q4) * 512 + d];
        }
        s *= (1.f / 256.f);
        const unsigned short hi = f2bf(s); const unsigned short lo = f2bf(s - bf2f(hi));
        *(LAS unsigned short*)(lds + OFF_KBH + n * KB_STR + d * 2) = hi; *(LAS unsigned short*)(lds + OFF_KBL + n * KB_STR + d * 2) = lo;
    }
    bf16x8 qf[4];
#pragma unroll
    for (int ks = 0; ks < 4; ++ks) qf[ks] = *(const GAS bf16x8*)(T.Q + (size_t)qidx * T.pitch + ks * 16 + h * 8);
    u32x4 rk1, rk2, rv; rk2 = (u32x4){0u, 0u, 0u, 0u};
    stage_load<64>(rk1, rk2, rv, T, own * 256, tid); stage_store<64>(lds, 0, 0, rk1, rk2, rv, tid);
    stage_load<64>(rk1, rk2, rv, T, own * 256 + 64, tid);
    __syncthreads();
    unsigned sel = 0u;
    {
        f32x16 g = splat16(0.f); const bf16x8 zf = (bf16x8){0, 0, 0, 0, 0, 0, 0, 0};
#pragma unroll
        for (int ks = 0; ks < 4; ++ks) {
            bf16x8 ah = *(const LAS bf16x8*)(lds + OFF_KBH + (r & 7) * KB_STR + ks * 32 + h * 16), al = *(const LAS bf16x8*)(lds + OFF_KBL + (r & 7) * KB_STR + ks * 32 + h * 16);
            if (r >= 8) { ah = zf; al = zf; }
            g = MFMA32(ah, qf[ks], g); g = MFMA32(al, qf[ks], g);
        }
        float gate[8];
#pragma unroll
        for (int i = 0; i < 4; ++i) { const float mine = g[i], other = __shfl_xor(mine, 32); gate[i] = h ? other : mine; gate[4 + i] = h ? mine : other; }
#pragma unroll
        for (int n = 0; n < 8; ++n) { int rank = 0;
#pragma unroll
            for (int j = 0; j < 8; ++j) if (j != n) rank += (j < own && (gate[j] > gate[n] || (gate[j] == gate[n] && j < n))) ? 1 : 0;
            if (n < own && rank < 3) sel |= 1u << n; }
    }
    f32x16 o[2]; o[0] = splat16(0.f); o[1] = splat16(0.f); f32x16 negm = splat16(0.f); float m = 0.f, l = 0.f;
    const float b31 = btab[127];
    const int nseq = 4 + 4 * own, adiag = wid >> 1;
    int cur = 0, vcur = 0, vnext = 1, vfree = 2;
    f32x16 p0 = splat16(0.f), p1 = splat16(0.f); const bool lead = wid < 4;
#define SEQT(i_) (((i_) < 4) ? own * 4 + (i_) : (i_) - 4)
#define MOBA_SYNC(i_) do { if (VAR != 2) { if ((i_) + 1 < nseq) stage_store<64>(lds, cur ^ 1, vnext, rk1, rk2, rv, tid); if ((i_) + 2 < nseq) stage_load<64>(rk1, rk2, rv, T, SEQT((i_) + 2) * 64, tid); } __syncthreads(); } while (0)
    for (int i = 0; i < nseq; ++i) {
        const int s0 = SEQT(i) * 64; const bool own_t = i < 4;
        const bool rowsel = own_t ? true : (((sel >> ((i - 4) >> 2)) & 1u) != 0u);
        const bool act = (VAR != 1) && (own_t ? (i <= adiag) : (__any(rowsel ? 1 : 0) != 0));
        if (act) moba_qk<VAR>(own_t && i == adiag, q0w - (s0 + 63) < 113, lds + OFF_K + cur * KBUF, qf, btab, b31, s0, qidx, rowsel, r, h, negm, p0, p1);
        if (!lead) MOBA_SYNC(i);
        if (act) att_smpv<VAR>(i == 0, lds + OFF_V + vcur * VBUF, lane, p0, p1, m, l, negm, o);
        if (lead) MOBA_SYNC(i);
        cur ^= 1; { const int tmp = vcur; vcur = vnext; vnext = vfree; vfree = tmp; }
    }
#undef MOBA_SYNC
#undef SEQT
    l += __shfl_xor(l, 32);
    store_o(o, 1.0f / l, T.O + (size_t)qidx * T.opitch, h);
    __syncthreads();
}

constexpr int SBW_V = 65536;
__device__ __forceinline__ void sbw_store(LAS unsigned char* lds, int slot, const u32x4& rk, const u32x4& rv, int tid) {
    const int row = tid >> 3, c = tid & 7;
    *(LAS u32x4*)(lds + slot * 8192 + row * 128 + ((c ^ ((row >> 1) & 7)) << 4)) = rk;
    *(LAS u32x4*)(lds + SBW_V + slot * 8192 + row * 128 + ((c ^ (((row >> 1) & 1) << 2)) << 4)) = rv;
}
__device__ __forceinline__ void sbw_load(u32x4& rk, u32x4& rv, const Tens& T, int s0, int tid) {
    const int row = tid >> 3, ch = tid & 7;
    rk = *(const GAS u32x4*)(T.K1 + (size_t)(s0 + row) * T.pitch + ch * 8);
    rv = *(const GAS u32x4*)(T.V + (size_t)(s0 + row) * T.pitch + ch * 8);
}
__device__ __forceinline__ void sb_tile(const LAS unsigned char* Kt, const LAS unsigned char* Vt, const bf16x8* qf, int s0, int qidx, bool mask, int r, int h, int lane, float& A, f32x16 (&o)[2]) {
    bf16x8 kf[8]; const int swz = (r >> 1) & 7;
#pragma unroll
    for (int ks = 0; ks < 4; ++ks) { const int cp = ((2 * ks + h) ^ swz) << 4; kf[2 * ks] = *(const LAS bf16x8*)(Kt + r * 128 + cp); kf[2 * ks + 1] = *(const LAS bf16x8*)(Kt + 4096 + r * 128 + cp); }
    __builtin_amdgcn_sched_barrier(0);
    f32x16 p0, p1; qk_pre<64>(p0, p1, kf, qf, splat16(0.f));
    f32x16 L0, L1;
#pragma unroll
    for (int i = 0; i < 16; ++i) {
        { const float z = p0[i], e = __builtin_amdgcn_exp2f(-fabsf(z)), lg = __builtin_amdgcn_logf(1.0f + e), ll = fmaxf(z, 0.f) + lg; L0[i] = -ll; p0[i] = z - ll; }
        { const float z = p1[i], e = __builtin_amdgcn_exp2f(-fabsf(z)), lg = __builtin_amdgcn_logf(1.0f + e), ll = fmaxf(z, 0.f) + lg; L1[i] = -ll; p1[i] = z - ll; }
    }
    if (mask) {
        asm volatile("" ::: "memory");
#pragma unroll
        for (int i = 0; i < 16; ++i) { if (!((s0 + crow(i, h)) < qidx)) L0[i] = 0.f; if (!((s0 + 32 + crow(i, h)) < qidx)) L1[i] = 0.f; }
    }
    float gs[8], tot[8], S[8];
#pragma unroll
    for (int g = 0; g < 4; ++g) { gs[g] = (L0[4 * g] + L0[4 * g + 1]) + (L0[4 * g + 2] + L0[4 * g + 3]); gs[4 + g] = (L1[4 * g] + L1[4 * g + 1]) + (L1[4 * g + 2] + L1[4 * g + 3]); }
#pragma unroll
    for (int j = 0; j < 8; ++j) { auto rr = __builtin_amdgcn_permlane32_swap(__float_as_uint(gs[j]), __float_as_uint(gs[j]), false, false); tot[j] = __uint_as_float(rr[0]) + __uint_as_float(rr[1]); }
    S[7] = 0.f;
#pragma unroll
    for (int j = 6; j >= 0; --j) S[j] = S[j + 1] + tot[j + 1];
    const float total = S[0] + tot[0];
#pragma unroll
    for (int j = 0; j < 8; ++j) {
        const float E = A + S[j] + (h == 0 ? (tot[j] - gs[j]) : 0.f);
        const int g = j & 3;
        if (j < 4) { const float c3 = E, c2 = c3 + L0[4 * g + 3], c1 = c2 + L0[4 * g + 2], c0 = c1 + L0[4 * g + 1];
            p0[4 * g + 3] = __builtin_amdgcn_exp2f(p0[4 * g + 3] + c3); p0[4 * g + 2] = __builtin_amdgcn_exp2f(p0[4 * g + 2] + c2); p0[4 * g + 1] = __builtin_amdgcn_exp2f(p0[4 * g + 1] + c1); p0[4 * g] = __builtin_amdgcn_exp2f(p0[4 * g] + c0); }
        else { const float c3 = E, c2 = c3 + L1[4 * g + 3], c1 = c2 + L1[4 * g + 2], c0 = c1 + L1[4 * g + 1];
            p1[4 * g + 3] = __builtin_amdgcn_exp2f(p1[4 * g + 3] + c3); p1[4 * g + 2] = __builtin_amdgcn_exp2f(p1[4 * g + 2] + c2); p1[4 * g + 1] = __builtin_amdgcn_exp2f(p1[4 * g + 1] + c1); p1[4 * g] = __builtin_amdgcn_exp2f(p1[4 * g] + c0); }
    }
    VFrags vf;
    { const int blk = (lane >> 4) & 1, q = (lane & 15) >> 2, pp = lane & 3, vflip = (q >> 1) & 1;
      const LAS unsigned char* vb = Vt + (4 * h + q) * 128 + blk * 32 + pp * 8;
#pragma unroll
      for (int kb = 0; kb < 2; ++kb)
#pragma unroll
          for (int s = 0; s < 2; ++s)
#pragma unroll
              for (int db = 0; db < 2; ++db) { const int off = (kb * 32 + 16 * s) * 128 + ((db ^ vflip) << 6); vf.lo[(kb * 2 + s) * 2 + db] = vtr(vb + off); vf.hi[(kb * 2 + s) * 2 + db] = vtr(vb + off + 8 * 128); }
      __builtin_amdgcn_sched_barrier(0); }
    if (mask) {
        asm volatile("" ::: "memory");
#pragma unroll
        for (int i = 0; i < 16; ++i) { if (!((s0 + crow(i, h)) < qidx)) p0[i] = 0.f; if (!((s0 + 32 + crow(i, h)) < qidx)) p1[i] = 0.f; }
    }
    A += total;
    pv_pre(o, p0, p1, vf);
}
__device__ __forceinline__ void sb_unit(LAS unsigned char* lds, const Tens& T, int qb, int tid, int wid, int lane) {
    const int r = lane & 31, h = lane >> 5, q0 = qb * 256, q0w = q0 + wid * 32, qidx = q0w + r;
    const int ttop = qb * 4 + 3, wtop = (q0w + 31) / 64, tlo = (ttop >= 7) ? ttop - 7 : 0;
    {
        for (int s4 = 0; s4 <= ttop - tlo; s4 += 4) { u32x4 rk[4], rv[4];
#pragma unroll
            for (int j = 0; j < 4; ++j) sbw_load(rk[j], rv[j], T, (tlo + s4 + j) * 64, tid);
#pragma unroll
            for (int j = 0; j < 4; ++j) sbw_store(lds, s4 + j, rk[j], rv[j], tid); }
    }
    bf16x8 qf[4];
#pragma unroll
    for (int ks = 0; ks < 4; ++ks) qf[ks] = *(const GAS bf16x8*)(T.Q + (size_t)qidx * T.pitch + ks * 16 + h * 8);
    f32x16 o[2]; o[0] = splat16(0.f); o[1] = splat16(0.f); float A = 0.f; bool done = false;
    volatile LAS unsigned* flags = (volatile LAS unsigned*)(lds + OFF_FLAG);
    __syncthreads();
    for (int t = wtop; t >= tlo; --t) {
        sb_tile(lds + (t - tlo) * 8192, lds + SBW_V + (t - tlo) * 8192, qf, t * 64, qidx, t == wtop, r, h, lane, A, o);
        done = __all(A <= -150.f ? 1 : 0) != 0;
        if (done) break;
    }
    if (lane == 0) flags[16 + wid] = (done || tlo == 0) ? 1u : 0u;
    __syncthreads();
    unsigned alld = 1u;
#pragma unroll
    for (int w = 0; w < 8; ++w) alld &= flags[16 + w];
    if (!alld) {
        u32x4 rk, rv; sbw_load(rk, rv, T, (tlo - 1) * 64, tid); sbw_store(lds, 0, rk, rv, tid); __syncthreads();
        int cur = 0, par = 0;
        for (int t = tlo - 1;; --t) {
            const bool more = t > 0;
            if (more) sbw_load(rk, rv, T, (t - 1) * 64, tid);
            if (!done) { sb_tile(lds + cur * 8192, lds + SBW_V + cur * 8192, qf, t * 64, qidx, false, r, h, lane, A, o); done = __all(A <= -150.f ? 1 : 0) != 0; }
            if (lane == 0) flags[par * 8 + wid] = done ? 1u : 0u;
            if (more) sbw_store(lds, cur ^ 1, rk, rv, tid);
            __syncthreads();
            unsigned ad = 1u;
#pragma unroll
            for (int w = 0; w < 8; ++w) ad &= flags[par * 8 + w];
            if (!more || ad) break;
            cur ^= 1; par ^= 1;
        }
    }
    store_o(o, 1.0f, T.O + (size_t)qidx * T.opitch, h);
    __syncthreads();
}
__device__ __forceinline__ int next_unit(LAS unsigned char* lds, gu32* head, int tid) {
    volatile LAS unsigned* w = (volatile LAS unsigned*)(lds + OFF_WORK);
    if (tid == 0) *w = __hip_atomic_fetch_add(head, 1u, RLX_AGENT);
    __syncthreads();
    const int u = (int)*w;
    __syncthreads();
    return u;
}
}

struct Args { const float* in[16]; float* out; unsigned char* ws; int ph_lo, ph_hi; };
__global__ void __launch_bounds__(NWAVES * 64, 2) fwd(Args args) {
    extern __shared__ __attribute__((aligned(16))) unsigned char lds_raw[];
    LAS unsigned char* lds = (LAS unsigned char*)lds_raw;
    volatile LAS unsigned* MISC = (volatile LAS unsigned*)(lds + MISC_OFF);
    const int tid = threadIdx.x, lane = tid & 63, wave = __builtin_amdgcn_readfirstlane(tid >> 6), wave0 = wave;
    const int G = gridDim.x, bx = blockIdx.x, vcu = (G % 8 == 0) ? (bx % 8) * (G / 8) + bx / 8 : bx;
    const int gw = vcu * NWAVES + wave, NGW = G * NWAVES;
    unsigned char* ws = args.ws;
    gu32* ctl = (gu32*)(ws + WS_CTL);
    const float* x = args.in[0]; float* hbuf = args.out;
    bf16_t* XN = (bf16_t*)(ws + WS_XN); bf16_t* ATT = (bf16_t*)(ws + WS_ATT); bf16_t* BIG = (bf16_t*)(ws + WS_BIG);
    const int lo = args.ph_lo, hi = args.ph_hi;
    for (int u = tid; u < (LDS_BYTES - LDSCTL_OFF) / 4; u += NWAVES * 64) ((LAS unsigned*)(lds + LDSCTL_OFF))[u] = 0u;
    __syncthreads();
    XcdBarrier bar; bar.bar = (unsigned*)(ctl + CW_BAR); bar.x = 0; bar.st = nullptr;
    if (hi - lo > 1) bar = xcd_barrier_post((unsigned*)(ctl + CW_BAR), MISC + 8);
    int ph = 0;
#define PH_ON (ph >= lo && ph < hi)
#define GRID_BAR() do { XcdBarrier b_ = bar; unsigned long long bv_ = (unsigned long long)b_.bar; asm volatile("" : "+s"(bv_)); b_.bar = (unsigned*)bv_; xcd_barrier(b_); } while (0)
#define PH_END do { if (PH_ON && ph + 1 < hi) { GRID_BAR(); if (NREP(8) > 1) GRID_BAR(); } ++ph; } while (0)

    if (PH_ON) { for (int rep = 0; rep < NREP(6); ++rep) { if (rep) GRID_BAR();
        {
            LAS float* su = (LAS float*)lds; LAS float* si = (LAS float*)(lds + 8192);
            for (int fi = bx; fi < 896; fi += G) {
                const int e = fi / 448; int rr = fi % 448; const float* Win = args.in[5] + (size_t)e * 1024 * 2208; bf16_t* WT = (bf16_t*)(ws + WS_WCAT + e * SZ_WCAT);
                if (rr < 192) p0_fuse_item(Win, 0, 384, args.in[7] + (size_t)e * 384 * 768, 768, args.in[6] + e * 384, args.in[1] + 2 * e * DM, WT, rr / 16, rr % 16, false, SC_MLA, su, si, tid);
                else { rr -= 192; p0_fuse_item(Win, 384, 256, args.in[9] + (size_t)e * 256 * 1024, 1024, args.in[8] + e * 256, args.in[1] + 2 * e * DM, WT, rr / 16, rr % 16, true, 1.f, su, si, tid); }
            }
            __syncthreads();
        }
        LAS float* scr = (LAS float*)(lds + wave * 16384);
        constexpr int I0 = 16 * 69, I1 = 16 * 32, I2 = 16 * 96, I3 = 16 * 32, I4 = 16 * 176, I5 = 44 * 32;
        constexpr int NIT = 2 * (I0 + I1 + I2 + I3) + 4 * (I4 + I5);
#define TR_DECODE(D_, it_) do { int rr = (it_); int mat, inst; (D_).gk = nullptr; \
            if (rr < 2 * I0) { mat = 0; inst = rr / I0; rr %= I0; (D_).N = 2208; (D_).K = 1024; (D_).W = args.in[5] + (size_t)inst * 1024 * 2208; (D_).WT = (bf16_t*)(ws + WS_WCAT + inst * SZ_WCAT); (D_).gk = args.in[1] + 2 * inst * DM; } \
            else if ((rr -= 2 * I0) < 2 * I1) { mat = 1; inst = rr / I1; rr %= I1; (D_).N = 1024; (D_).K = 1024; (D_).W = args.in[10] + (size_t)inst * 1024 * 1024; (D_).WT = (bf16_t*)(ws + WS_WOAB + inst * SZ_WO); } \
            else if ((rr -= 2 * I1) < 2 * I2) { mat = 2; inst = rr / I2; rr %= I2; (D_).N = 3072; (D_).K = 1024; (D_).W = args.in[12] + (size_t)inst * 1024 * 3072; (D_).WT = (bf16_t*)(ws + WS_WQKV + inst * SZ_WQKV); (D_).gk = args.in[1] + (2 * inst + 1) * DM; } \
            else if ((rr -= 2 * I2) < 2 * I3) { mat = 3; inst = rr / I3; rr %= I3; (D_).N = 1024; (D_).K = 1024; (D_).W = args.in[13] + (size_t)inst * 1024 * 1024; (D_).WT = (bf16_t*)(ws + WS_WOSB + inst * SZ_WO); } \
            else if ((rr -= 2 * I3) < 4 * I4) { mat = 4; inst = rr / I4; rr %= I4; (D_).N = 5632; (D_).K = 1024; (D_).W = args.in[14] + (size_t)inst * 1024 * 5632; (D_).WT = (bf16_t*)(ws + WS_WGU + inst * SZ_WGU); (D_).gk = args.in[3] + inst * DM; } \
            else { rr -= 4 * I4; mat = 5; inst = rr / I5; rr %= I5; (D_).N = 1024; (D_).K = 2816; (D_).W = args.in[15] + (size_t)inst * 2816 * 1024; (D_).WT = (bf16_t*)(ws + WS_WDN + inst * SZ_WDN); } \
            const int nblk = (D_).N / 32; (D_).kb = rr / nblk; (D_).n0 = (rr % nblk) * 32; map_group(mat, (D_).n0, (D_).dst, (D_).sc); } while (0)
        {
            TrDesc dA, dB; float tA[32], tB[32]; int it = gw;
            if (it < NIT) { TR_DECODE(dA, it); p0_tr_load(dA, tA, lane); }
            for (; it < NIT; it += 2 * NGW) {
                const bool hb = it + NGW < NIT; if (hb) { TR_DECODE(dB, it + NGW); p0_tr_load(dB, tB, lane); }
                p0_tr_process(dA, tA, scr, lane);
                if (it + 2 * NGW < NIT) { TR_DECODE(dA, it + 2 * NGW); p0_tr_load(dA, tA, lane); }
                if (hb) p0_tr_process(dB, tB, scr, lane);
            }
        }
#undef TR_DECODE
        for (int rw = gw; rw < 192; rw += NGW) {
            bf16_t* p = (bf16_t*)(ws + WS_WCAT + (rw / 96) * SZ_WCAT) + (size_t)(C_PAD + rw % 96) * 1024;
            ((GAS u32x4*)p)[lane] = (u32x4){0u, 0u, 0u, 0u}; ((GAS u32x4*)p)[64 + lane] = (u32x4){0u, 0u, 0u, 0u};
        }
        for (int idx = vcu * 512 + tid; idx < SEQ * 16; idx += G * 512) {
            const int pos = idx >> 4, i = idx & 15;
            const float inv = exp2f(-(float)i * (13.287712379549449f / 16.f)); const float ang = (float)pos * inv;
            const double rev = (double)ang * 0.15915494309189535; const float fr = (float)(rev - floor(rev));
            ((GAS float*)(ws + WS_ROPE))[2 * idx] = __builtin_amdgcn_cosf(fr); ((GAS float*)(ws + WS_ROPE))[2 * idx + 1] = __builtin_amdgcn_sinf(fr);
        }
        if (NGW * 16 == M) {
            f32x4 xv[4][4];
#define X_LOAD(k_) do { const float* xr = x + (size_t)(gw + (k_) * NGW) * DM; _Pragma("unroll") for (int j = 0; j < 4; ++j) xv[(k_) % 4][j] = ((const GAS f32x4*)xr)[lane + 64 * j]; } while (0)
#pragma unroll
            for (int k = 0; k < 4; ++k) X_LOAD(k);
#pragma unroll
            for (int k = 0; k < 16; ++k) { const size_t m = (size_t)(gw + k * NGW); float sx = 0.f;
#pragma unroll
                for (int j = 0; j < 4; ++j) { const f32x4 v = xv[k % 4][j]; sx += (v.x * v.x + v.y * v.y) + (v.z * v.z + v.w * v.w);
                    u32x2 w; w.x = cvt_pk_bf16(v.x, v.y); w.y = cvt_pk_bf16(v.z, v.w); ((GAS u32x2*)((bf16_t*)hbuf + m * DM))[lane + 64 * j] = w; }
                const float rr_ = __builtin_amdgcn_rsqf(wave_sum(sx) * (1.f / DM) + RMS_EPS); if (lane == 0) ((float*)(ws + WS_RSX))[m] = rr_;
                if (k + 4 < 16) X_LOAD(k + 4); }
#undef X_LOAD
        } else for (int m = gw; m < M; m += NGW) x_row_to_bf16(x + (size_t)m * DM, (bf16_t*)hbuf + (size_t)m * DM, (float*)(ws + WS_RSX) + m, lane);
    } }
    PH_END;

    unsigned char* const ws_top = ws;
    for (int L = 0; L < DEPTH; ++L) {
        const int e = L >> 1; const bool even = (L & 1) == 0;
        unsigned long long wsv = (unsigned long long)ws_top; asm volatile("" : "+s"(wsv)); unsigned char* ws = (unsigned char*)wsv;
        gu32* ctl = (gu32*)(ws + WS_CTL); bf16_t* XN = (bf16_t*)(ws + WS_XN); bf16_t* ATT = (bf16_t*)(ws + WS_ATT); bf16_t* BIG = (bf16_t*)(ws + WS_BIG);
        if (PH_ON) {
            const int N = even ? NPROJ : NQKV;
            pg8::Gemm g{(const bf16_t*)hbuf, (const bf16_t*)(ws + (even ? WS_WCAT + e * SZ_WCAT : WS_WQKV + e * SZ_WQKV)), M, N, DM};
            pg8::StaticOrder S; S.init(M, N, G, bx); pg8::EpiBf16 E{BIG, even ? PPROJ : PQKV, (const float*)(ws + WS_RSX)};
            for (int rep = 0; rep < NREP(0); ++rep) { if (rep) GRID_BAR();
            pg8::gemm_phase<pg8::EpiBf16, pg8::StaticOrder, true, true>(lds, g, S, E, fresh_tid(wave)); }
        }
        PH_END;
        if (even) {
            if (PH_ON) {
                const int lane = fresh_tid(wave) & 63;
                const float* cs = (const float*)(ws + WS_ROPE);
                { int m = gw;
                  for (; m + 3 * NGW < M; m += 4 * NGW) { const int pos[4] = {m & (SEQ - 1), (m + NGW) & (SEQ - 1), (m + 2 * NGW) & (SEQ - 1), (m + 3 * NGW) & (SEQ - 1)}; prep_rows<4>(BIG + (size_t)m * PPROJ, (size_t)NGW * PPROJ, cs, pos, lane); }
                  for (; m < M; m += NGW) { const int pos[1] = {m & (SEQ - 1)}; prep_rows<1>(BIG + (size_t)m * PPROJ, 0, cs, pos, lane); } }
                float* kbp = (float*)(ws + WS_KBP);
                for (int it = gw; it < 512; it += NGW) {
                    const int b = it >> 5, n = (it >> 2) & 7, q4 = it & 3;
                    const bf16_t* src = BIG + (size_t)(b * SEQ + n * 256 + q4 * 64) * PPROJ + C_MK + lane * 8; float a[8];
#pragma unroll
                    for (int j = 0; j < 8; ++j) a[j] = 0.f;
                    for (int r0 = 0; r0 < 64; r0 += 16) { u32x4 w[16];
#pragma unroll
                        for (int rr = 0; rr < 16; ++rr) w[rr] = *(const GAS u32x4*)(src + (size_t)(r0 + rr) * PPROJ);
#pragma unroll
                        for (int rr = 0; rr < 16; ++rr) { a[0] += bflo(w[rr].x); a[1] += bfhi(w[rr].x); a[2] += bflo(w[rr].y); a[3] += bfhi(w[rr].y); a[4] += bflo(w[rr].z); a[5] += bfhi(w[rr].z); a[6] += bflo(w[rr].w); a[7] += bfhi(w[rr].w); } }
                    float* dst = kbp + (size_t)((b * 8 + n) * 4 + q4) * 512 + lane * 8;
                    *(GAS f32x4*)dst = (f32x4){a[0], a[1], a[2], a[3]}; *(GAS f32x4*)(dst + 4) = (f32x4){a[4], a[5], a[6], a[7]};
                }
            }
            PH_END;
        }
        if (PH_ON) {
            const int tid = fresh_tid(wave0), lane = tid & 63, wave = wave0;
            if (even) {
                {
                    LAS float* bt = (LAS float*)(lds + att::OFF_BIAS);
                    for (int idx = tid; idx < 1024; idx += NWAVES * 64) { const int hh = idx >> 7, rel = idx & 127; int bk = rel;
                        if (rel >= 16) { bk = 15 + (rel >= 16) + (rel >= 19) + (rel >= 21) + (rel >= 24) + (rel >= 27) + (rel >= 31) + (rel >= 35) + (rel >= 40) + (rel >= 46) + (rel >= 52) + (rel >= 59) + (rel >= 67) + (rel >= 77) + (rel >= 87) + (rel >= 99) + (rel >= 113); }
                        bt[idx] = args.in[11][bk * 8 + hh] * LOG2E; }
                    __syncthreads();
                }
#define ATT_EVEN_PASS(VAR_, OB_, QO_) do { \
                gu32* head0 = ctl + CW_Q + 64 * (2 * L + (QO_)), * head1 = ctl + CW_Q + 64 * (2 * L + 1 + (QO_)); \
                { const int tid1 = fresh_tid(wave0), lane1 = tid1 & 63; \
                for (;;) {     \
                    const int u = att::next_unit(lds, head0, tid1); if (u >= 1024) break; \
                    const int qb = 7 - (u >> 7), bh = u & 127, b = bh >> 3, hh = bh & 7; \
                    const bf16_t* base = BIG + (size_t)b * SEQ * PPROJ; \
                    att::Tens T{base + C_Q + hh * 96, base + C_KN + hh * 64, base + C_KR, base + C_V + hh * 64, (OB_) + (size_t)b * SEQ * DM + hh * 64, PPROJ, DM}; \
                    att::mla_unit<VAR_>(lds, T, qb, tid1, wave0, lane1); \
                } } \
                { const int tid2 = fresh_tid(wave0), lane2 = tid2 & 63;     \
                for (;;) {     \
                    const int u = att::next_unit(lds, head1, tid2); if (u >= 1024) break; \
                    const int qb = 7 - (u >> 7), bh = u & 127, b = bh >> 3, hh = bh & 7; \
                    const bf16_t* base = BIG + (size_t)b * SEQ * PPROJ; \
                    att::Tens T{base + C_MQ + hh * 64, base + C_MK + hh * 64, nullptr, base + C_MV + hh * 64, (OB_) + (size_t)b * SEQ * DM + 512 + hh * 64, PPROJ, DM}; \
                    att::moba_unit<VAR_>(lds, T, (const float*)(ws + WS_KBP) + (size_t)b * 8 * 4 * 512 + hh * 64, (const LAS float*)(lds + att::OFF_BIAS) + hh * 128, qb, tid2, wave0, lane2); \
                } } } while (0)
#if (PROBE_DUP >> 1) & 1
                ATT_EVEN_PASS(PROBE_VAR, XN, 8); GRID_BAR();
#endif
                ATT_EVEN_PASS(0, ATT, 0);
#undef ATT_EVEN_PASS
            } else {
                for (int rep = 0; rep < NREP(2); ++rep) { if (rep) GRID_BAR();
                gu32* head0 = ctl + CW_Q + 64 * (2 * L + 8 * rep);
                for (;;) {
                    const int u = att::next_unit(lds, head0, tid); if (u >= 2048) break;
                    const int qb = 7 - (u >> 8), bh = u & 255, b = bh >> 4, hh = bh & 15;
                    const bf16_t* base = BIG + (size_t)b * SEQ * PQKV;
                    att::Tens T{base + hh * 64, base + 1024 + hh * 64, nullptr, base + 2048 + hh * 64, ATT + (size_t)b * SEQ * DM + hh * 64, PQKV, DM};
                    att::sb_unit(lds, T, qb, tid, wave, lane);
                }
                }
            }
        }
        PH_END;
        if (PH_ON) {
            pg8::Gemm g{ATT, (const bf16_t*)(ws + (even ? WS_WOAB : WS_WOSB) + e * SZ_WO), M, DM, DM};
            pg8::StaticOrder S; S.init(M, DM, G, bx); pg8::EpiBf16 E{BIG, DM, nullptr};
            for (int rep = 0; rep < NREP(3); ++rep) { if (rep) GRID_BAR();
            pg8::gemm_phase<pg8::EpiBf16, pg8::StaticOrder, true, true>(lds, g, S, E, fresh_tid(wave)); }
        }
        PH_END;
        if (PH_ON) {
            const int lane = fresh_tid(wave) & 63;
            bf16_t* h16 = (bf16_t*)hbuf; bf16_t* hmid = (bf16_t*)(ws + WS_BIG + 192 * MiB);
            for (int rep = 0; rep < NREP(7); ++rep) { if (rep) GRID_BAR();
            resnorm_phase<true>(h16, BIG, args.in[2] + L * DM, hmid, (float*)(ws + WS_RSY), gw, NGW, lane); }
        }
        PH_END;
        if (PH_ON) {
            pg8::Gemm g{(const bf16_t*)(ws + WS_BIG + 192 * MiB), (const bf16_t*)(ws + WS_WGU + L * SZ_WGU), M, 2 * DFF, DM};
            pg8::StaticOrder S; S.init(M, 2 * DFF, G, bx); pg8::EpiSwiGLU E{BIG, DFF, (const float*)(ws + WS_RSY)};
            for (int rep = 0; rep < NREP(4); ++rep) { if (rep) GRID_BAR();
            pg8::gemm_phase<pg8::EpiSwiGLU, pg8::StaticOrder, true, true>(lds, g, S, E, fresh_tid(wave)); }
        }
        PH_END;
        if (PH_ON) {
            pg8::Gemm g{BIG, (const bf16_t*)(ws + WS_WDN + L * SZ_WDN), M, DM, DFF};
            pg8::StaticOrder S; S.init(M, DM, G, bx); pg8::EpiBf16 E{ATT, DM, nullptr};
            for (int rep = 0; rep < NREP(5); ++rep) { if (rep) GRID_BAR();
            pg8::gemm_phase<pg8::EpiBf16, pg8::StaticOrder, true, true>(lds, g, S, E, fresh_tid(wave)); }
        }
        PH_END;
        if (PH_ON) {
            const int lane = fresh_tid(wave) & 63;
            const bf16_t* hmid = (const bf16_t*)(ws + WS_BIG + 192 * MiB);
            for (int rep = 0; rep < NREP(7); ++rep) { if (rep) GRID_BAR();
            if (L + 1 < DEPTH) resnorm_phase<true>(hmid, ATT, args.in[4] + L * DM, (bf16_t*)hbuf, (float*)(ws + WS_RSX), gw, NGW, lane);
            else resnorm_phase<false>(hmid, ATT, args.in[4] + L * DM, hbuf, nullptr, gw, NGW, lane); }
        }
        PH_END;
    }
#undef PH_ON
#undef PH_END
}

extern "C" void kernel_launch(void* const* d_in, const int* in_sizes, int n_in, void* d_out, int out_size, void* d_ws, size_t ws_size, hipStream_t stream) {
    static int grid = 0;
    if (grid == 0) {
        if (n_in != 16 || in_sizes[0] != M * DM || out_size != M * DM || ws_size < WS_END) { fprintf(stderr, "kernel_launch: unexpected shapes / workspace (n_in %d, ws %zu); nothing launched\n", n_in, ws_size); grid = -1; return; }
        int dev = 0, cus = 0;
        if (hipGetDevice(&dev) != hipSuccess || hipDeviceGetAttribute(&cus, hipDeviceAttributeMultiprocessorCount, dev) != hipSuccess) { grid = -1; return; }
        if (hipFuncSetAttribute((const void*)fwd, hipFuncAttributeMaxDynamicSharedMemorySize, LDS_BYTES) != hipSuccess) { fprintf(stderr, "kernel_launch: hipFuncSetAttribute failed\n"); grid = -1; return; }
        int per_cu = 0;
        if (hipOccupancyMaxActiveBlocksPerMultiprocessor(&per_cu, (const void*)fwd, NWAVES * 64, LDS_BYTES) != hipSuccess || per_cu < 1) { fprintf(stderr, "kernel_launch: occupancy query says %d blocks per CU\n", per_cu); }
        (void)hipGetLastError();
        grid = cus;
    }
    if (grid < 0) return;
    if (hipMemsetAsync((char*)d_ws + WS_CTL, 0, CTL_ZERO_BYTES, stream) != hipSuccess) return;
    Args a{};
    for (int i = 0; i < 16; ++i) a.in[i] = (const float*)d_in[i];
    a.out = (float*)d_out; a.ws = (unsigned char*)d_ws;
#if MK_PER_PHASE
    for (int p = 0; p < N_PHASES; ++p) { a.ph_lo = p; a.ph_hi = p + 1; hipLaunchKernelGGL(fwd, dim3(grid), dim3(NWAVES * 64), LDS_BYTES, stream, a); }
#else
    a.ph_lo = 0; a.ph_hi = N_PHASES;
    hipLaunchKernelGGL(fwd, dim3(grid), dim3(NWAVES * 64), LDS_BYTES, stream, a);
#endif
}
```

```cpp
#include <hip/hip_runtime.h>
#include <cstdio>
#include <cstdint>
namespace pg8 {
#define PG8_LAS __attribute__((address_space(3)))
typedef unsigned short bf16_t;
typedef short bf16x8 __attribute__((ext_vector_type(8)));
typedef float f32x4 __attribute__((ext_vector_type(4)));
typedef unsigned u32x4 __attribute__((ext_vector_type(4)));
constexpr int BM = 256, BK = 64, HALF = 128, HTB = HALF * BK * 2  , STAGE_BYTES = 8 * HTB, NXCD = 8, WGM = 8;

__host__ __device__ __forceinline__ int lds_byte(int r, int c) { const int st = (r >> 4) * 2 + (c >> 5), rr = r & 15, cc = c & 31, ob = rr * 64 + cc * 2; return st * 1024 + (ob ^ (((ob >> 9) & 1) << 5)); }
__host__ __device__ __forceinline__ void stage_rc(int b, int& R, int& C) { const int st = b / 1024, sb = b % 1024, swz = sb ^ (((sb >> 9) & 1) << 5); R = (st >> 1) * 16 + swz / 64; C = (st & 1) * 32 + (swz % 64) / 2; }
__host__ __device__ __forceinline__ int perm32(int rho) { const int n = rho >> 4, i = rho & 15; return 8 * (i >> 2) + 4 * n + (i & 3); }

struct Unit { int pm, pn; };
struct Gemm { const bf16_t* A; const bf16_t* Bt; int M, N, K; };

struct StaticOrder {
    int nM, nN, nwg, G, c;
    __host__ __device__ void init(int M, int N, int G_, int c_) { nM = M / BM; nN = N / BM; nwg = nM * nN; G = G_; c = c_; }
    __host__ __device__ bool next(int i, Unit& u) const {
        const long L = (long)i * G + c; if (L >= nwg) return false;
        int wgid = (int)L; { const int q = nwg / NXCD, r = nwg % NXCD, xcd = wgid % NXCD, off = wgid / NXCD; wgid = (xcd < r ? xcd * (q + 1) : r * (q + 1) + (xcd - r) * q) + off; }
        const int nig = WGM * nN, gid = wgid / nig, fm = gid * WGM, gsz = (nM - fm) < WGM ? (nM - fm) : WGM;
        u.pm = fm + ((wgid % nig) % gsz); u.pn = (wgid % nig) / gsz; return true;
    }
    __device__ __forceinline__ void a_ready(const Unit&) const {}
    __device__ __forceinline__ void done(const Unit&) const {}
};

typedef float f32x2_t __attribute__((ext_vector_type(2))); typedef __bf16 bf16x2_t __attribute__((ext_vector_type(2)));
__device__ __forceinline__ unsigned cvt_pk_bf16(float lo, float hi) { f32x2_t v = {lo, hi}; bf16x2_t b = __builtin_convertvector(v, bf16x2_t); return __builtin_bit_cast(unsigned, b); }

struct EpiBf16 {
    static constexpr bool PERM = true, AFTER_DRAIN = false;
    bf16_t* O; int ldc; const float* rs;
    __device__ __forceinline__ void operator()(const f32x4 (&acc)[2][2][4][2], const Unit& u, int wr, int wc, int fr, int fq) const {
        const int row0 = u.pm * BM + wr * 64 + fr; const int col0 = u.pn * BM + wc * 32 + 8 * fq;
#pragma unroll
        for (int ai = 0; ai < 2; ++ai)
#pragma unroll
            for (int m = 0; m < 4; ++m) { bf16_t* rowp = O + (size_t)(row0 + ai * HALF + m * 16) * ldc + col0; const float sc = rs ? rs[row0 + ai * HALF + m * 16] : 1.f;
#pragma unroll
                for (int bj = 0; bj < 2; ++bj) { const f32x4 v0 = acc[ai][bj][m][0] * sc, v1 = acc[ai][bj][m][1] * sc;
                    u32x4 w; w.x = cvt_pk_bf16(v0[0], v0[1]); w.y = cvt_pk_bf16(v0[2], v0[3]); w.z = cvt_pk_bf16(v1[0], v1[1]); w.w = cvt_pk_bf16(v1[2], v1[3]);
                    *(u32x4*)(rowp + bj * HALF) = w; } }
    }
};
struct EpiSwiGLU {
    static constexpr bool PERM = true, AFTER_DRAIN = false;
    bf16_t* O; int ldc; const float* rs;
    __device__ __forceinline__ void operator()(const f32x4 (&acc)[2][2][4][2], const Unit& u, int wr, int wc, int fr, int fq) const {
        const int row0 = u.pm * BM + wr * 64 + fr; const int col0 = u.pn * HALF + wc * 32 + 8 * fq;
#pragma unroll
        for (int ai = 0; ai < 2; ++ai)
#pragma unroll
            for (int m = 0; m < 4; ++m) { bf16_t* rowp = O + (size_t)(row0 + ai * HALF + m * 16) * ldc + col0; const float sc = rs[row0 + ai * HALF + m * 16];
                float r[8];
#pragma unroll
                for (int n = 0; n < 2; ++n)
#pragma unroll
                    for (int j = 0; j < 4; ++j) { const float g = acc[ai][0][m][n][j] * sc, up = acc[ai][1][m][n][j] * sc;
                        const float s = __builtin_amdgcn_rcpf(1.0f + __builtin_amdgcn_exp2f(-1.4426950408889634f * g)); r[n * 4 + j] = g * s * up; }
                u32x4 w; w.x = cvt_pk_bf16(r[0], r[1]); w.y = cvt_pk_bf16(r[2], r[3]); w.z = cvt_pk_bf16(r[4], r[5]); w.w = cvt_pk_bf16(r[6], r[7]);
                *(u32x4*)rowp = w; }
    }
};

template <class Epi, class Sched, bool ALIGN_EPI = false, bool SP2 = false>
__device__ __forceinline__ void gemm_phase(PG8_LAS unsigned char* lds, const Gemm g, const Sched& S, const Epi& E, const int tid_in) {
    const int tid = tid_in, wid = __builtin_amdgcn_readfirstlane(tid >> 6), lane = tid & 63, wr = wid >> 2, wc = wid & 3, fr = lane & 15, fq = lane >> 4;
    const int K = g.K, nt = K / BK;
    unsigned voffA[2], voffB[2];
#pragma unroll
    for (int i = 0; i < 2; ++i) { int R, C; stage_rc(tid * 16 + i * 8192, R, C); const int Rb = Epi::PERM ? ((R & ~31) + perm32(R & 31)) : R;
        voffA[i] = (unsigned)(R * K + C) * 2u; voffB[i] = (unsigned)(Rb * K + C) * 2u; }
    const size_t kstep = (size_t)(BK * 2);
    const size_t hstep = (size_t)HALF * K * 2;
    const size_t tstep = 2 * hstep;
    const unsigned ldsw = (unsigned)wid * 1024u;
    const int aoff = lds_byte(wr * 64 + fr, fq * 8), boff = lds_byte(wc * 32 + fr, fq * 8);
#define PG8_SA(b, h) (((b) * 2 + (h)) * HTB)
#define PG8_SB(b, h) ((4 + (b) * 2 + (h)) * HTB)
#define PG8_STAGE(bufoff, gbase, voff) do { _Pragma("unroll") for (int _i = 0; _i < 2; ++_i) \
        __builtin_amdgcn_global_load_lds((const unsigned*)((const char*)(gbase) + (voff)[_i]), (PG8_LAS unsigned*)(lds + (bufoff) + ldsw + _i * 8192), 16, 0, 0); } while (0)
#define PG8_LDA(dst, b, h) do { _Pragma("unroll") for (int m = 0; m < 4; ++m) _Pragma("unroll") for (int k = 0; k < 2; ++k) dst[m][k] = *(const PG8_LAS bf16x8*)(lds + PG8_SA(b, h) + aoff + m * 2048 + k * 1024); } while (0)
#define PG8_LDB(dst, b, h) do { _Pragma("unroll") for (int n = 0; n < 2; ++n) _Pragma("unroll") for (int k = 0; k < 2; ++k) dst[n][k] = *(const PG8_LAS bf16x8*)(lds + PG8_SB(b, h) + boff + n * 2048 + k * 1024); } while (0)
#define PG8_MMA(ai, bj, At, Bt) do { __builtin_amdgcn_s_setprio(1); _Pragma("unroll") for (int m = 0; m < 4; ++m) _Pragma("unroll") for (int n = 0; n < 2; ++n) _Pragma("unroll") for (int k = 0; k < 2; ++k) \
        acc[ai][bj][m][n] = __builtin_amdgcn_mfma_f32_16x16x32_bf16(Bt[n][k], At[m][k], acc[ai][bj][m][n], 0, 0, 0); __builtin_amdgcn_s_setprio(0); } while (0)
#define PG8_WAIT_V(n) asm volatile("s_waitcnt vmcnt(" #n ")" ::: "memory")
#define PG8_WAIT_L(n) asm volatile("s_waitcnt lgkmcnt(" #n ")" ::: "memory")
#define PG8_BAR __builtin_amdgcn_s_barrier()
#define PG8_SCHED __builtin_amdgcn_sched_barrier(0)
    Unit cur, nxt; int ui = 0;
    if (!S.next(0, cur)) return;
    f32x4 acc[2][2][4][2];
#pragma unroll
    for (int a = 0; a < 2; ++a)
#pragma unroll
        for (int b = 0; b < 2; ++b)
#pragma unroll
            for (int m = 0; m < 4; ++m)
#pragma unroll
                for (int n = 0; n < 2; ++n) acc[a][b][m][n] = (f32x4){0.f, 0.f, 0.f, 0.f};
    bf16x8 At[4][2], B0[2][2], B1[2][2];
    const char* cA = (const char*)g.A + (size_t)cur.pm * tstep; const char* cB = (const char*)g.Bt + (size_t)cur.pn * tstep;
    S.a_ready(cur);
    if constexpr (SP2) {
        PG8_STAGE(PG8_SB(0, 0), cB, voffB); PG8_STAGE(PG8_SB(0, 1), cB + hstep, voffB); PG8_STAGE(PG8_SA(0, 0), cA, voffA); PG8_STAGE(PG8_SA(0, 1), cA + hstep, voffA);
        if (wr == 1) PG8_BAR;
        PG8_WAIT_V(2); PG8_BAR;
        PG8_STAGE(PG8_SB(1, 0), cB + kstep, voffB); PG8_STAGE(PG8_SA(1, 0), cA + kstep, voffA); PG8_STAGE(PG8_SB(1, 1), cB + hstep + kstep, voffB);
        PG8_WAIT_V(6); PG8_BAR;
    } else {
        PG8_STAGE(PG8_SB(0, 0), cB, voffB); PG8_STAGE(PG8_SA(0, 0), cA, voffA); PG8_STAGE(PG8_SB(0, 1), cB + hstep, voffB); PG8_STAGE(PG8_SA(0, 1), cA + hstep, voffA);
        if (wr == 1) PG8_BAR;
        PG8_WAIT_V(4); PG8_BAR;
        PG8_STAGE(PG8_SB(1, 0), cB + kstep, voffB); PG8_STAGE(PG8_SA(1, 0), cA + kstep, voffA); PG8_STAGE(PG8_SB(1, 1), cB + hstep + kstep, voffB);
        PG8_WAIT_V(6); PG8_BAR;
    }
    for (;;) {
        const bool has_next = S.next(ui + 1, nxt);
        const char* nA = has_next ? (const char*)g.A + (size_t)nxt.pm * tstep : cA; const char* nB = has_next ? (const char*)g.Bt + (size_t)nxt.pn * tstep : cB;
        for (int t = 0; t < nt; t += 2) {
            const bool last = (t == nt - 2);
            const char* a1 = cA + (size_t)(t + 1) * kstep;
            const char* a2 = last ? nA : cA + (size_t)(t + 2) * kstep; const char* b2 = last ? nB : cB + (size_t)(t + 2) * kstep;
            const char* a3 = a2 + kstep; const char* b3 = b2 + kstep;
            if (last && has_next) S.a_ready(nxt);
            if constexpr (SP2) {
            PG8_LDB(B0, 0, 0); PG8_LDB(B1, 0, 1); PG8_SCHED; PG8_LDA(At, 0, 0); PG8_STAGE(PG8_SA(1, 1), a1 + hstep, voffA);
            PG8_WAIT_V(8); PG8_WAIT_L(0); PG8_BAR; PG8_MMA(0, 0, At, B0); PG8_MMA(0, 1, At, B1); PG8_BAR; PG8_SCHED;
            PG8_LDA(At, 0, 1); PG8_STAGE(PG8_SB(0, 0), b2, voffB); PG8_STAGE(PG8_SB(0, 1), b2 + hstep, voffB); PG8_STAGE(PG8_SA(0, 0), a2, voffA);
            PG8_WAIT_V(8); PG8_WAIT_L(0); PG8_BAR; PG8_MMA(1, 0, At, B0); PG8_MMA(1, 1, At, B1); PG8_BAR; PG8_SCHED;
            PG8_LDB(B0, 1, 0); PG8_LDB(B1, 1, 1); PG8_SCHED; PG8_LDA(At, 1, 0); PG8_STAGE(PG8_SA(0, 1), a2 + hstep, voffA);
            PG8_WAIT_V(8); PG8_WAIT_L(0); PG8_BAR; PG8_MMA(0, 0, At, B0); PG8_MMA(0, 1, At, B1); PG8_BAR; PG8_SCHED;
            PG8_LDA(At, 1, 1); PG8_STAGE(PG8_SB(1, 0), b3, voffB); PG8_STAGE(PG8_SB(1, 1), b3 + hstep, voffB); PG8_STAGE(PG8_SA(1, 0), a3, voffA);
            PG8_WAIT_V(8); PG8_WAIT_L(0); PG8_BAR; PG8_MMA(1, 0, At, B0); PG8_MMA(1, 1, At, B1); PG8_BAR; PG8_SCHED;
            } else {
            PG8_LDB(B0, 0, 0); PG8_SCHED; PG8_LDA(At, 0, 0); PG8_STAGE(PG8_SA(1, 1), a1 + hstep, voffA);
            PG8_WAIT_L(8); PG8_BAR; PG8_WAIT_L(0); PG8_MMA(0, 0, At, B0); PG8_BAR; PG8_SCHED;
            PG8_LDB(B1, 0, 1); PG8_STAGE(PG8_SB(0, 0), b2, voffB);
            PG8_BAR; PG8_WAIT_L(0); PG8_MMA(0, 1, At, B1); PG8_BAR;
            PG8_LDA(At, 0, 1); PG8_STAGE(PG8_SA(0, 0), a2, voffA);
            PG8_BAR; PG8_WAIT_L(0); PG8_MMA(1, 0, At, B0); PG8_BAR; PG8_SCHED;
            PG8_STAGE(PG8_SB(0, 1), b2 + hstep, voffB);
            PG8_WAIT_V(6); PG8_BAR; PG8_MMA(1, 1, At, B1); PG8_BAR;
            PG8_LDB(B0, 1, 0); PG8_SCHED; PG8_LDA(At, 1, 0); PG8_STAGE(PG8_SA(0, 1), a2 + hstep, voffA);
            PG8_WAIT_L(8); PG8_BAR; PG8_WAIT_L(0); PG8_MMA(0, 0, At, B0); PG8_BAR; PG8_SCHED;
            PG8_LDB(B1, 1, 1); PG8_STAGE(PG8_SB(1, 0), b3, voffB);
            PG8_BAR; PG8_WAIT_L(0); PG8_MMA(0, 1, At, B1); PG8_BAR;
            PG8_LDA(At, 1, 1); PG8_STAGE(PG8_SA(1, 0), a3, voffA);
            PG8_BAR; PG8_WAIT_L(0); PG8_MMA(1, 0, At, B0); PG8_BAR; PG8_SCHED;
            PG8_STAGE(PG8_SB(1, 1), b3 + hstep, voffB);
            PG8_WAIT_V(6); PG8_BAR; PG8_MMA(1, 1, At, B1); PG8_BAR;
            }
        }
        if constexpr (ALIGN_EPI) { if (wr == 0) PG8_BAR; }
        if constexpr (!Epi::AFTER_DRAIN) { E(acc, cur, wr, wc, fr, fq); S.done(cur); }
        if (!has_next) break;
#pragma unroll
        for (int a = 0; a < 2; ++a)
#pragma unroll
            for (int b = 0; b < 2; ++b)
#pragma unroll
                for (int m = 0; m < 4; ++m)
#pragma unroll
                    for (int n = 0; n < 2; ++n) acc[a][b][m][n] = (f32x4){0.f, 0.f, 0.f, 0.f};
        cur = nxt; cA = nA; cB = nB; ++ui;
        if constexpr (ALIGN_EPI) { if (wr == 1) PG8_BAR; }
    }
    PG8_WAIT_V(0);
    if constexpr (!ALIGN_EPI) { if (wr == 0) PG8_BAR; }
    PG8_BAR;
    if constexpr (Epi::AFTER_DRAIN) { E.fused(acc, cur, wr, wc, fr, fq, lds, wid, lane); S.done(cur); }
#undef PG8_SA
#undef PG8_SB
#undef PG8_STAGE
#undef PG8_LDA
#undef PG8_LDB
#undef PG8_MMA
#undef PG8_WAIT_V
#undef PG8_WAIT_L
#undef PG8_BAR
#undef PG8_SCHED
}
}

#define GAS __attribute__((address_space(1)))
#define LAS __attribute__((address_space(3)))
typedef unsigned short bf16_t;
typedef unsigned u32x4 __attribute__((ext_vector_type(4)));
typedef unsigned u32x2 __attribute__((ext_vector_type(2)));
typedef float f32x4 __attribute__((ext_vector_type(4)));
typedef float f32x16 __attribute__((ext_vector_type(16)));
typedef short bf16x8 __attribute__((ext_vector_type(8)));
typedef short s16x4 __attribute__((ext_vector_type(4)));
typedef GAS unsigned gu32;
#define RLX_AGENT __ATOMIC_RELAXED, __HIP_MEMORY_SCOPE_AGENT
#define LDS_WAIT() asm volatile("s_waitcnt lgkmcnt(0)" ::: "memory")
#define VM_WAIT() asm volatile("s_waitcnt vmcnt(0)" ::: "memory")
using pg8::cvt_pk_bf16;
__device__ __forceinline__ float bf2f(unsigned short b) { return __uint_as_float(((unsigned)b) << 16); }
__device__ __forceinline__ float bflo(unsigned w) { return __uint_as_float(w << 16); }
__device__ __forceinline__ float bfhi(unsigned w) { return __uint_as_float(w & 0xffff0000u); }
__device__ __forceinline__ unsigned short f2bf(float f) { return (unsigned short)(cvt_pk_bf16(f, 0.f) & 0xffffu); }

#define XB_TMO      128
#define XB_XCNT(j)  (256  + 64 * (j))
#define XB_XSUB(j)  (1280 + 64 * (j))
#define XB_XGEN(j)  (2304 + 64 * (j))
#define XB_TOP      3328
#define XB_TOPGEN   3392
#define XCD_BAR_WORDS 3456
#define XB_SPIN_CAP (1u << 18)

__device__ __forceinline__ unsigned xb_ld(unsigned* p)              { return __hip_atomic_load(p, __ATOMIC_RELAXED, __HIP_MEMORY_SCOPE_AGENT); }
__device__ __forceinline__ unsigned xb_add(unsigned* p, unsigned v) { return __hip_atomic_fetch_add(p, v, __ATOMIC_RELAXED, __HIP_MEMORY_SCOPE_AGENT); }
__device__ __forceinline__ unsigned xb_xcc_id() { return (unsigned)__builtin_amdgcn_s_getreg((3 << 11) | 20) & 0xFu; }
#define XB_SPIN(cond, bar) do { unsigned _sp = 0; while (cond) { __builtin_amdgcn_s_sleep(1); \
    if ((++_sp & 255u) == 0u) { if (xb_ld(&(bar)[XB_TMO])) break; if (_sp > XB_SPIN_CAP) { atomicAdd(&(bar)[XB_TMO], 1u); break; } } } } while (0)

struct XcdBarrier {
    unsigned* bar; unsigned x;
    volatile LAS unsigned* st;
};

__device__ __forceinline__ XcdBarrier xcd_barrier_post(unsigned* bar, volatile LAS unsigned* st) {
    XcdBarrier b; b.bar = bar; b.x = xb_xcc_id(); b.st = st;
    if (threadIdx.x == 0) (void)xb_add(&bar[XB_XCNT(b.x)], 1u);
    return b;
}
__device__ __forceinline__ void xcd_barrier_complete(unsigned* bar, unsigned x, unsigned& nloc, unsigned& nx) {
    const unsigned G = gridDim.x * gridDim.y * gridDim.z;
    unsigned sum, cnt, mine, sp = 0u;
    for (;;) {
        sum = 0u; cnt = 0u; mine = 0u;
#pragma unroll
        for (unsigned j = 0; j < 16; ++j) { const unsigned c = xb_ld(&bar[XB_XCNT(j)]); sum += c; cnt += (c > 0u) ? 1u : 0u; mine = (j == x) ? c : mine; }
        if (sum == G) break;
        __builtin_amdgcn_s_sleep(1);
        if ((++sp & 255u) == 0u) { if (xb_ld(&bar[XB_TMO])) break; if (sp > XB_SPIN_CAP) { atomicAdd(&bar[XB_TMO], 1u); break; } }
    }
    nloc = mine > 0u ? mine : 1u; nx = cnt > 0u ? cnt : 1u;
}

__device__ __forceinline__ void xcd_barrier(const XcdBarrier& b) {
    asm volatile("s_waitcnt vmcnt(0)" ::: "memory");
    __syncthreads();
    if (threadIdx.x == 0) {
        unsigned* bar = b.bar;
        __builtin_amdgcn_s_waitcnt(0);
        unsigned nloc = b.st[0], nx = b.st[1];
        if (nloc == 0u) { xcd_barrier_complete(bar, b.x, nloc, nx); b.st[0] = nloc; b.st[1] = nx; }
        const unsigned old = xb_add(&bar[XB_XSUB(b.x)], 1u);
        const unsigned gen = old / nloc;
        if (old + 1u == (gen + 1u) * nloc) {
            __builtin_amdgcn_fence(__ATOMIC_RELEASE, "agent");
            asm volatile("s_waitcnt vmcnt(0)" ::: "memory");
            const unsigned og = xb_add(&bar[XB_TOP], 1u);
            const unsigned tg = og / nx;
            if (og + 1u == (tg + 1u) * nx) xb_add(&bar[XB_TOPGEN], 1u);
            else XB_SPIN(xb_ld(&bar[XB_TOPGEN]) == tg, bar);
            __builtin_amdgcn_fence(__ATOMIC_ACQUIRE, "agent");
            xb_add(&bar[XB_XGEN(b.x)], 1u);
            asm volatile("s_waitcnt vmcnt(0)" ::: "memory");
        } else {
            XB_SPIN(xb_ld(&bar[XB_XGEN(b.x)]) == gen, bar);
            __builtin_amdgcn_fence(__ATOMIC_ACQUIRE, "agent");
            asm volatile("s_waitcnt vmcnt(0)" ::: "memory");
        }
    }
    __syncthreads();
}

#ifndef MK_PER_PHASE
#define MK_PER_PHASE 0
#endif
#ifndef PROBE_DUP
#define PROBE_DUP 0
#endif
#define NREP(bit) ((PROBE_DUP >> (bit)) & 1 ? 2 : 1)
#ifndef PROBE_VAR
#define PROBE_VAR 0
#endif
constexpr int NWAVES = 8;
constexpr int BATCH = 16, SEQ = 2048, DM = 1024, M = BATCH * SEQ, DEPTH = 4, DFF = 2816;
constexpr int NPROJ = 4096, NQKV = 3072;
constexpr int PPROJ = 4160, PQKV = 3136;
constexpr int C_Q = 0, C_KN = 768, C_V = 1280, C_KR = 1792, C_CQ = 1824, C_CKV = 2208, C_PAD = 2464, C_MQ = 2560, C_MK = 3072, C_MV = 3584;
constexpr float RMS_EPS = 1e-6f, LOG2E = 1.4426950408889634f;
constexpr float SC_MLA = 0.10206207261596575f * LOG2E, SC_64 = 0.125f * LOG2E;

constexpr size_t MiB = 1u << 20;
constexpr size_t WS_CTL = 0, CTL_ZERO_BYTES = 1 * MiB;
constexpr size_t WS_ROPE = 1 * MiB;
constexpr size_t WS_KBP = 2 * MiB;
constexpr size_t WS_RSX = 3 * MiB, WS_RSY = 3 * MiB + 512 * 1024;
constexpr size_t WS_WCAT = 4 * MiB, WS_WOAB = 20 * MiB, WS_WQKV = 24 * MiB, WS_WOSB = 36 * MiB, WS_WGU = 40 * MiB, WS_WDN = 84 * MiB;
constexpr size_t SZ_WCAT = 8 * MiB, SZ_WO = 2 * MiB, SZ_WQKV = 6 * MiB, SZ_WGU = 11 * MiB, SZ_WDN = 5632 * 1024;
constexpr size_t WS_XN = 106 * MiB, WS_ATT = 170 * MiB, WS_BIG = 234 * MiB, WS_END = 496 * MiB;
static_assert(WS_WDN + 4 * SZ_WDN <= WS_XN && WS_BIG + (size_t)M * PPROJ * 2 <= WS_END, "d_ws map");
constexpr int CW_TMO = 0, CW_BAR = 4096, CW_Q = 8192;
constexpr int RING_BYTES = 131072, LDSCTL_OFF = RING_BYTES, MISC_OFF = LDSCTL_OFF + 320, LDS_BYTES = 147456;
constexpr int N_PHASES = 31;

__device__ __forceinline__ int launder(int v) { asm volatile("" : "+v"(v)); return v; }
__device__ __forceinline__ int fresh_tid(int wave_s) { unsigned z = 0u; asm volatile("" : "+v"(z)); return wave_s * 64 + (int)__builtin_amdgcn_mbcnt_hi(~0u, __builtin_amdgcn_mbcnt_lo(~0u, z)); }
__device__ __forceinline__ float wave_sum(float v) {
#pragma unroll
    for (int o = 1; o < 64; o <<= 1) v += __shfl_xor(v, o);
    return v;
}

__device__ __forceinline__ void p0_tr_item(const float* W, int N, int K, bf16_t* WT, int kb, int n0, int dst_row, float sc, const float* gk  , LAS float* scr, int lane) {
    const int k0 = 64 * kb;
    float tv[32];
#pragma unroll
    for (int i = 0; i < 32; ++i) tv[i] = *(const GAS float*)(W + (size_t)(k0 + 2 * i + (lane >> 5)) * N + n0 + (lane & 31));
#pragma unroll
    for (int i = 0; i < 32; ++i) scr[(2 * i + (lane >> 5)) * 33 + (lane & 31)] = tv[i];
    LDS_WAIT(); asm volatile("" ::: "memory");
    const int c = lane & 7; float gs[8];
#pragma unroll
    for (int q = 0; q < 8; ++q) gs[q] = gk ? gk[k0 + 8 * c + q] * sc : sc;
#pragma unroll
    for (int j = 0; j < 4; ++j) { const int n = (lane >> 3) + 8 * j; const LAS float* s = scr + (8 * c) * 33 + n;
        u32x4 o; o.x = cvt_pk_bf16(s[0 * 33] * gs[0], s[1 * 33] * gs[1]); o.y = cvt_pk_bf16(s[2 * 33] * gs[2], s[3 * 33] * gs[3]);
        o.z = cvt_pk_bf16(s[4 * 33] * gs[4], s[5 * 33] * gs[5]); o.w = cvt_pk_bf16(s[6 * 33] * gs[6], s[7 * 33] * gs[7]);
        *(GAS u32x4*)(WT + (size_t)(dst_row + n) * K + k0 + 8 * c) = o; }
    LDS_WAIT(); asm volatile("" ::: "memory");
}
__device__ __forceinline__ void map_group(int mat, int n0, int& dst, float& sc) {
    sc = 1.f; dst = n0;
    if (mat == 0) { if (n0 < 384) dst = C_CQ + n0; else if (n0 < 640) dst = C_CKV + (n0 - 384); else if (n0 < 672) dst = C_KR + (n0 - 640); else { dst = C_MQ + (n0 - 672); if (n0 < 1184) sc = SC_64; } }
    else if (mat == 2) { if (n0 < 1024) sc = SC_64; }
    else if (mat == 4) { if (n0 < DFF) dst = 256 * (n0 >> 7) + (n0 & 127); else { const int n1 = n0 - DFF; dst = 256 * (n1 >> 7) + 128 + (n1 & 127); } }
}
__device__ __forceinline__ void p0_fuse_item(const float* Win, int roff, int R, const float* Wu, int NU, const float* g, const float* gpre  , bf16_t* WT, int nt, int kt, bool is_kv, float sc, LAS float* su, LAS float* si, int tid) {
    const int tn = tid & 63, tk = tid >> 6; float acc[8];
#pragma unroll
    for (int j = 0; j < 8; ++j) acc[j] = 0.f;
    for (int r0 = 0; r0 < R; r0 += 32) {
        __syncthreads();
#pragma unroll
        for (int i = 0; i < 4; ++i) { const int rr = (tid >> 6) + 8 * i; su[rr * 64 + tn] = Wu[(size_t)(r0 + rr) * NU + nt * 64 + tn] * g[r0 + rr]; }
#pragma unroll
        for (int i = 0; i < 4; ++i) { const int k = (tid >> 5) + 16 * i, rr = tid & 31; si[k * 36 + rr] = Win[(size_t)(kt * 64 + k) * 2208 + roff + r0 + rr]; }
        __syncthreads();
#pragma unroll 2
        for (int r4 = 0; r4 < 32; r4 += 4) {
            const float a0 = su[(r4 + 0) * 64 + tn], a1 = su[(r4 + 1) * 64 + tn], a2 = su[(r4 + 2) * 64 + tn], a3 = su[(r4 + 3) * 64 + tn];
#pragma unroll
            for (int j = 0; j < 8; ++j) { const f32x4 b = *(const LAS f32x4*)(si + (tk * 8 + j) * 36 + r4); acc[j] += a0 * b.x + a1 * b.y + a2 * b.z + a3 * b.w; }
        }
    }
    const int n = nt * 64 + tn;
    const int dst = is_kv ? (((n & 127) < 64) ? C_KN + (n >> 7) * 64 + (n & 127) : C_V + (n >> 7) * 64 + (n & 127) - 64) : n;
#pragma unroll
    for (int j = 0; j < 8; ++j) acc[j] *= sc * gpre[kt * 64 + tk * 8 + j];
    u32x4 o; o.x = cvt_pk_bf16(acc[0], acc[1]); o.y = cvt_pk_bf16(acc[2], acc[3]); o.z = cvt_pk_bf16(acc[4], acc[5]); o.w = cvt_pk_bf16(acc[6], acc[7]);
    *(GAS u32x4*)(WT + (size_t)dst * 1024 + kt * 64 + tk * 8) = o;
}
__device__ __forceinline__ void x_row_to_bf16(const float* xrow, bf16_t* orow, float* rs, int lane) {
    f32x4 v[4]; float s = 0.f;
#pragma unroll
    for (int j = 0; j < 4; ++j) { v[j] = ((const GAS f32x4*)xrow)[lane + 64 * j]; s += (v[j].x * v[j].x + v[j].y * v[j].y) + (v[j].z * v[j].z + v[j].w * v[j].w); }
    const float r = __builtin_amdgcn_rsqf(wave_sum(s) * (1.f / DM) + RMS_EPS);
    if (lane == 0) *rs = r;
#pragma unroll
    for (int j = 0; j < 4; ++j) { u32x2 w; w.x = cvt_pk_bf16(v[j].x, v[j].y); w.y = cvt_pk_bf16(v[j].z, v[j].w); ((GAS u32x2*)orow)[lane + 64 * j] = w; }
}
template <bool HOUT16> __device__ __forceinline__ void resnorm_one(const u32x2 (&hw)[4], const u32x2 (&dw)[4], const f32x4 (&gg)[4], void* hout_, float* rs, int lane) {
    float s = 0.f;
#pragma unroll
    for (int j = 0; j < 4; ++j) { const float a = bflo(dw[j].x), b = bfhi(dw[j].x), c = bflo(dw[j].y), d = bfhi(dw[j].y); s += (a * a + b * b) + (c * c + d * d); }
    const float rd = __builtin_amdgcn_rsqf(wave_sum(s) * (1.f / DM) + RMS_EPS); float s2 = 0.f;
#pragma unroll
    for (int j = 0; j < 4; ++j) { const f32x4 dv = (f32x4){bflo(dw[j].x), bfhi(dw[j].x), bflo(dw[j].y), bfhi(dw[j].y)};
        const f32x4 hv = (f32x4){bflo(hw[j].x), bfhi(hw[j].x), bflo(hw[j].y), bfhi(hw[j].y)} + dv * rd * gg[j];
        if (HOUT16) { u32x2 w; w.x = cvt_pk_bf16(hv.x, hv.y); w.y = cvt_pk_bf16(hv.z, hv.w); ((GAS u32x2*)hout_)[lane + 64 * j] = w; }
        else ((GAS f32x4*)hout_)[lane + 64 * j] = hv;
        s2 += (hv.x * hv.x + hv.y * hv.y) + (hv.z * hv.z + hv.w * hv.w); }
    if (rs) { const float r2 = __builtin_amdgcn_rsqf(wave_sum(s2) * (1.f / DM) + RMS_EPS); if (lane == 0) *rs = r2; }
}
template <bool HOUT16> __device__ __forceinline__ void resnorm_phase(const bf16_t* hin, const bf16_t* D, const float* gp, void* hout, float* rs, int gw, int NGW, int lane) {
    const size_t ob = HOUT16 ? 2 : 4;
    f32x4 gg[4];
#pragma unroll
    for (int j = 0; j < 4; ++j) gg[j] = ((const GAS f32x4*)gp)[lane + 64 * j];
    if (NGW * 16 == M) {
        constexpr int DEPTH_ = 6; u32x2 hw[DEPTH_][4], dw[DEPTH_][4];
#define RN_LOAD(k_) do { const size_t mm = (size_t)(gw + (k_) * NGW) * DM; _Pragma("unroll") for (int j = 0; j < 4; ++j) { hw[(k_) % DEPTH_][j] = ((const GAS u32x2*)(hin + mm))[lane + 64 * j]; dw[(k_) % DEPTH_][j] = ((const GAS u32x2*)(D + mm))[lane + 64 * j]; } } while (0)
#pragma unroll
        for (int k = 0; k < DEPTH_; ++k) RN_LOAD(k);
#pragma unroll
        for (int k = 0; k < 16; ++k) { const size_t m = (size_t)(gw + k * NGW);
            resnorm_one<HOUT16>(hw[k % DEPTH_], dw[k % DEPTH_], gg, (char*)hout + m * DM * ob, rs ? rs + m : nullptr, lane);
            if (k + DEPTH_ < 16) RN_LOAD(k + DEPTH_); }
#undef RN_LOAD
    } else {
        for (int m = gw; m < M; m += NGW) { u32x2 hw[4], dw[4];
#pragma unroll
            for (int j = 0; j < 4; ++j) { hw[j] = ((const GAS u32x2*)(hin + (size_t)m * DM))[lane + 64 * j]; dw[j] = ((const GAS u32x2*)(D + (size_t)m * DM))[lane + 64 * j]; }
            resnorm_one<HOUT16>(hw, dw, gg, (char*)hout + (size_t)m * DM * ob, rs ? rs + m : nullptr, lane); }
    }
}
__device__ __forceinline__ float ssq8(const u32x4 w) { float s = 0.f; const unsigned a[4] = {w.x, w.y, w.z, w.w};
#pragma unroll
    for (int i = 0; i < 4; ++i) { const float lo = bflo(a[i]), hi = bfhi(a[i]); s += lo * lo + hi * hi; } return s; }
__device__ __forceinline__ u32x4 scale8(const u32x4 w, float s) { u32x4 o; o.x = cvt_pk_bf16(bflo(w.x) * s, bfhi(w.x) * s); o.y = cvt_pk_bf16(bflo(w.y) * s, bfhi(w.y) * s);
    o.z = cvt_pk_bf16(bflo(w.z) * s, bfhi(w.z) * s); o.w = cvt_pk_bf16(bflo(w.w) * s, bfhi(w.w) * s); return o; }
template <int R> __device__ __forceinline__ void prep_rows(bf16_t* P0, size_t rstride  , const float* cs0, const int (&pos)[R], int lane) {
    u32x4 wq[R], wk[R], qn[R], kn[R], vv[R], x1[R], x2[R]; f32x4 ct[R][4];
    const int o = lane & 1; const bool isq = lane < 16;
#pragma unroll
    for (int r = 0; r < R; ++r) { bf16_t* P = P0 + r * rstride;
        wq[r] = (u32x4){0u, 0u, 0u, 0u}; wk[r] = wq[r]; x1[r] = wq[r]; x2[r] = wq[r];
        if (lane < 48) wq[r] = *(const GAS u32x4*)(P + C_CQ + lane * 8);
        if (lane < 32) wk[r] = *(const GAS u32x4*)(P + C_CKV + lane * 8);
        qn[r] = *(const GAS u32x4*)(P + C_Q + (lane >> 3) * 96 + (lane & 7) * 8);
        kn[r] = *(const GAS u32x4*)(P + C_KN + lane * 8);
        vv[r] = *(const GAS u32x4*)(P + C_V + lane * 8);
        if (lane < 18) { const bf16_t* a1 = isq ? P + C_Q + (lane >> 1) * 96 + 64 + o * 8 : P + C_KR + o * 8; x1[r] = *(const GAS u32x4*)a1; x2[r] = *(const GAS u32x4*)(a1 + 16);
#pragma unroll
            for (int i = 0; i < 4; ++i) ct[r][i] = *(const GAS f32x4*)(cs0 + (size_t)pos[r] * 32 + (o * 8 + 2 * i) * 2); }
    }
    float sq[R], sk[R];
#pragma unroll
    for (int r = 0; r < R; ++r) { sq[r] = ssq8(wq[r]); sk[r] = ssq8(wk[r]); }
#pragma unroll
    for (int off = 1; off < 64; off <<= 1)
#pragma unroll
        for (int r = 0; r < R; ++r) { sq[r] += __shfl_xor(sq[r], off); sk[r] += __shfl_xor(sk[r], off); }
#pragma unroll
    for (int r = 0; r < R; ++r) { bf16_t* P = P0 + r * rstride;
        const float rq = __builtin_amdgcn_rsqf(sq[r] * (1.f / 384.f) + RMS_EPS), rkv = __builtin_amdgcn_rsqf(sk[r] * (1.f / 256.f) + RMS_EPS);
        *(GAS u32x4*)(P + C_Q + (lane >> 3) * 96 + (lane & 7) * 8) = scale8(qn[r], rq);
        *(GAS u32x4*)(P + C_KN + lane * 8) = scale8(kn[r], rkv);
        *(GAS u32x4*)(P + C_V + lane * 8) = scale8(vv[r], rkv);
        if (lane < 18) {
            const float sc = isq ? rq : 1.f; bf16_t* a1 = isq ? P + C_Q + (lane >> 1) * 96 + 64 + o * 8 : P + C_KR + o * 8;
            const unsigned y1[4] = {x1[r].x, x1[r].y, x1[r].z, x1[r].w}, y2[4] = {x2[r].x, x2[r].y, x2[r].z, x2[r].w}; unsigned o1[4], o2[4];
#pragma unroll
            for (int i = 0; i < 4; ++i) { const f32x4 c = ct[r][i];
                const float a = bflo(y1[i]) * sc, b = bflo(y2[i]) * sc, a_ = bfhi(y1[i]) * sc, b_ = bfhi(y2[i]) * sc;
                o1[i] = cvt_pk_bf16(a * c.x - b * c.y, a_ * c.z - b_ * c.w); o2[i] = cvt_pk_bf16(a * c.y + b * c.x, a_ * c.w + b_ * c.z); }
            *(GAS u32x4*)a1 = (u32x4){o1[0], o1[1], o1[2], o1[3]}; *(GAS u32x4*)(a1 + 16) = (u32x4){o2[0], o2[1], o2[2], o2[3]};
        }
    }
}

namespace att {
typedef short v4i16_t __attribute__((ext_vector_type(4)));
constexpr int VS = 192, KBUF = 64 * 208, VBUF = 64 * VS;
constexpr int OFF_K = 0, OFF_V = 2 * KBUF, OFF_FLAG = LDSCTL_OFF + 1024, OFF_WORK = OFF_FLAG + 128, OFF_BIAS = OFF_V + 3 * VBUF + 128, OFF_KBH = OFF_BIAS + 8 * 128 * 4, KB_STR = 144, OFF_KBL = OFF_KBH + 8 * KB_STR, OFF_END = OFF_KBL + 8 * KB_STR;
static_assert(OFF_END <= RING_BYTES && (OFF_BIAS % 16) == 0 && (OFF_KBH % 16) == 0 && (OFF_KBL % 16) == 0, "attention LDS map");
struct Tens { const bf16_t* Q; const bf16_t* K1; const bf16_t* K2; const bf16_t* V; bf16_t* O; int pitch, opitch; };
#define MFMA32(a, b, c) __builtin_amdgcn_mfma_f32_32x32x16_bf16((a), (b), (c), 0, 0, 0)
__device__ __forceinline__ int crow(int i, int h) { return (i & 3) + 8 * (i >> 2) + 4 * h; }
__device__ __forceinline__ s16x4 vtr(const LAS unsigned char* p) { return __builtin_bit_cast(s16x4, __builtin_amdgcn_ds_read_tr16_b64_v4i16((LAS v4i16_t*)p)); }
__device__ __forceinline__ bf16x8 pack8(const f32x16& x, int s) { u32x4 p; p.x = cvt_pk_bf16(x[8 * s], x[8 * s + 1]); p.y = cvt_pk_bf16(x[8 * s + 2], x[8 * s + 3]); p.z = cvt_pk_bf16(x[8 * s + 4], x[8 * s + 5]); p.w = cvt_pk_bf16(x[8 * s + 6], x[8 * s + 7]); return __builtin_bit_cast(bf16x8, p); }

template <int DK> __device__ __forceinline__ void stage_load(u32x4& rk1, u32x4& rk2, u32x4& rv, const Tens& T, int s0, int tid) {
    const int row = tid >> 3, ch = tid & 7;
    rk1 = *(const GAS u32x4*)(T.K1 + (size_t)(s0 + row) * T.pitch + ch * 8);
    rv = *(const GAS u32x4*)(T.V + (size_t)(s0 + row) * T.pitch + ch * 8);
    if (DK == 96) { if (tid < 256) rk2 = *(const GAS u32x4*)(T.K2 + (size_t)(s0 + (tid >> 2)) * T.pitch + (tid & 3) * 8); }
}
template <int DK> __device__ __forceinline__ void stage_store(LAS unsigned char* lds, int kslot, int vslot, const u32x4& rk1, const u32x4& rk2, const u32x4& rv, int tid) {
    constexpr int KSTR = DK * 2 + 16;
    *(LAS u32x4*)(lds + OFF_K + kslot * KBUF + (tid >> 3) * KSTR + (tid & 7) * 16) = rk1;
    *(LAS u32x4*)(lds + OFF_V + vslot * VBUF + (tid >> 3) * VS + (tid & 7) * 16) = rv;
    if (DK == 96) { if (tid < 256) *(LAS u32x4*)(lds + OFF_K + kslot * KBUF + (tid >> 2) * KSTR + 128 + (tid & 3) * 16) = rk2; }
}
template <int DK> __device__ __forceinline__ void qk(f32x16& p0, f32x16& p1, const LAS unsigned char* Kb, const bf16x8* qf, int r, int h, const f32x16& init) {
    constexpr int KSTR = DK * 2 + 16;
    p0 = init; p1 = init;
#pragma unroll
    for (int ks = 0; ks < DK / 16; ++ks) {
        const bf16x8 a0 = *(const LAS bf16x8*)(Kb + r * KSTR + ks * 32 + h * 16);
        const bf16x8 a1 = *(const LAS bf16x8*)(Kb + (32 + r) * KSTR + ks * 32 + h * 16);
        p0 = MFMA32(a0, qf[ks], p0); p1 = MFMA32(a1, qf[ks], p1);
    }
}
__device__ __forceinline__ void pv(f32x16 (&o)[2], const f32x16& p0, const f32x16& p1, const LAS unsigned char* Vb, int lane) {
    const int h = lane >> 5, blk = (lane >> 4) & 1, q = (lane & 15) >> 2, pp = lane & 3;
    const LAS unsigned char* vb = Vb + (4 * h + q) * VS + blk * 32 + pp * 8;
#pragma unroll
    for (int kb = 0; kb < 2; ++kb)
#pragma unroll
        for (int s = 0; s < 2; ++s) {
            const bf16x8 xs = pack8(kb ? p1 : p0, s);
#pragma unroll
            for (int db = 0; db < 2; ++db) {
                const s16x4 lo = vtr(vb + (kb * 32 + 16 * s) * VS + db * 64), hi = vtr(vb + (kb * 32 + 16 * s + 8) * VS + db * 64);
                const bf16x8 vf = __builtin_shufflevector(lo, hi, 0, 1, 2, 3, 4, 5, 6, 7);
                o[db] = MFMA32(vf, xs, o[db]);
            }
        }
}
struct VFrags { s16x4 lo[8], hi[8]; };
template <int DK> __device__ __forceinline__ void load_kfrags(bf16x8 (&kf)[2 * (DK / 16)], const LAS unsigned char* Kb, int r, int h) {
    constexpr int KSTR = DK * 2 + 16;
#pragma unroll
    for (int ks = 0; ks < DK / 16; ++ks) { kf[2 * ks] = *(const LAS bf16x8*)(Kb + r * KSTR + ks * 32 + h * 16); kf[2 * ks + 1] = *(const LAS bf16x8*)(Kb + (32 + r) * KSTR + ks * 32 + h * 16); }
    __builtin_amdgcn_sched_barrier(0);
}
__device__ __forceinline__ void load_vfrags(VFrags& vf, const LAS unsigned char* Vb, int lane) {
    const int h = lane >> 5, blk = (lane >> 4) & 1, q = (lane & 15) >> 2, pp = lane & 3;
    const LAS unsigned char* vb = Vb + (4 * h + q) * VS + blk * 32 + pp * 8;
#pragma unroll
    for (int kb = 0; kb < 2; ++kb)
#pragma unroll
        for (int s = 0; s < 2; ++s)
#pragma unroll
            for (int db = 0; db < 2; ++db) { vf.lo[(kb * 2 + s) * 2 + db] = vtr(vb + (kb * 32 + 16 * s) * VS + db * 64); vf.hi[(kb * 2 + s) * 2 + db] = vtr(vb + (kb * 32 + 16 * s + 8) * VS + db * 64); }
    __builtin_amdgcn_sched_barrier(0);
}
template <int DK> __device__ __forceinline__ void qk_pre(f32x16& p0, f32x16& p1, const bf16x8 (&kf)[2 * (DK / 16)], const bf16x8* qf, const f32x16& init) {
    p0 = init; p1 = init;
#pragma unroll
    for (int ks = 0; ks < DK / 16; ++ks) { p0 = MFMA32(kf[2 * ks], qf[ks], p0); p1 = MFMA32(kf[2 * ks + 1], qf[ks], p1); }
}
__device__ __forceinline__ void pv_pre(f32x16 (&o)[2], const f32x16& p0, const f32x16& p1, const VFrags& vf) {
#pragma unroll
    for (int kb = 0; kb < 2; ++kb)
#pragma unroll
        for (int s = 0; s < 2; ++s) {
            const bf16x8 xs = pack8(kb ? p1 : p0, s);
#pragma unroll
            for (int db = 0; db < 2; ++db) { const bf16x8 v = __builtin_shufflevector(vf.lo[(kb * 2 + s) * 2 + db], vf.hi[(kb * 2 + s) * 2 + db], 0, 1, 2, 3, 4, 5, 6, 7); o[db] = MFMA32(v, xs, o[db]); }
        }
}
__device__ __forceinline__ float rowmax32(const f32x16& p0, const f32x16& p1) {
    float a = fmaxf(p0[0], p1[0]);
#pragma unroll
    for (int i = 1; i < 16; ++i) a = fmaxf(a, fmaxf(p0[i], p1[i]));
    auto rr = __builtin_amdgcn_permlane32_swap(__float_as_uint(a), __float_as_uint(a), false, false);
    return fmaxf(__uint_as_float(rr[0]), __uint_as_float(rr[1]));
}
__device__ __forceinline__ void sm_step(bool first, f32x16& p0, f32x16& p1, float& m, float& l, f32x16& negm, f32x16 (&o)[2]) {
    const float mx = rowmax32(p0, p1);
    if (first || __any(mx > 8.0f ? 1 : 0)) {
        asm volatile("" ::: "memory");
        const float d = first ? mx : fmaxf(mx, 0.f), a = first ? 0.f : __builtin_amdgcn_exp2f(-d); m += d; l *= a;
#pragma unroll
        for (int i = 0; i < 16; ++i) { p0[i] -= d; p1[i] -= d; o[0][i] *= a; o[1][i] *= a; negm[i] = -m; }
    }
    float ps = 0.f;
#pragma unroll
    for (int i = 0; i < 16; ++i) { p0[i] = __builtin_amdgcn_exp2f(p0[i]); p1[i] = __builtin_amdgcn_exp2f(p1[i]); ps += p0[i] + p1[i]; }
    l += ps;
}
__device__ __forceinline__ void store_o(const f32x16 (&o)[2], float inv, bf16_t* orow, int h) {
#pragma unroll
    for (int db = 0; db < 2; ++db)
#pragma unroll
        for (int g = 0; g < 4; ++g) { u32x2 w; w.x = cvt_pk_bf16(o[db][4 * g] * inv, o[db][4 * g + 1] * inv); w.y = cvt_pk_bf16(o[db][4 * g + 2] * inv, o[db][4 * g + 3] * inv);
            *(GAS u32x2*)(orow + db * 32 + 8 * g + 4 * h) = w; }
}
__device__ __forceinline__ f32x16 splat16(float v) { f32x16 x;
#pragma unroll
    for (int i = 0; i < 16; ++i) x[i] = v; return x; }

template <int VAR> __device__ __forceinline__ void att_smpv(bool first, const LAS unsigned char* Vb, int lane, f32x16& p0, f32x16& p1, float& m, float& l, f32x16& negm, f32x16 (&o)[2]) {
    VFrags vf; load_vfrags(vf, Vb, lane);
    if (VAR != 3) sm_step(first, p0, p1, m, l, negm, o);
    if (VAR != 4) pv_pre(o, p0, p1, vf); else { o[0][0] += p0[3] + (float)vf.lo[0][0] + (float)vf.hi[7][1]; }
}
template <int VAR> __device__ __forceinline__ void mla_qk(bool mask, const LAS unsigned char* Kb, const bf16x8* qf, int s0, int qidx, int r, int h, const f32x16& negm, f32x16& p0, f32x16& p1) {
    bf16x8 kf[12];
    load_kfrags<96>(kf, Kb, r, h);
    if (VAR != 4) qk_pre<96>(p0, p1, kf, qf, negm); else { p0 = negm; p1 = negm; p0[0] += (float)kf[0][0] + (float)kf[11][7]; p1[1] += (float)kf[5][3]; }
    if (mask) {
        asm volatile("" ::: "memory");
#pragma unroll
        for (int i = 0; i < 16; ++i) { const int kv = s0 + crow(i, h); if (kv > qidx) p0[i] = -INFINITY; if (kv + 32 > qidx) p1[i] = -INFINITY; }
    }
}
template <int VAR> __device__ __forceinline__ void mla_unit(LAS unsigned char* lds, const Tens& T, int qb, int tid, int wid, int lane) {
    const int r = lane & 31, h = lane >> 5, q0 = qb * 256, q0w = q0 + wid * 32, qidx = q0w + r;
    bf16x8 qf[6];
#pragma unroll
    for (int ks = 0; ks < 6; ++ks) qf[ks] = *(const GAS bf16x8*)(T.Q + (size_t)qidx * T.pitch + ks * 16 + h * 8);
    f32x16 o[2]; o[0] = splat16(0.f); o[1] = splat16(0.f); f32x16 negm = splat16(0.f); float m = 0.f, l = 0.f;
    const int NT = (q0 + 256) / 64, wtop = (q0w + 31) / 64;
    u32x4 rk1, rk2, rv; rk2 = (u32x4){0u, 0u, 0u, 0u};
    stage_load<96>(rk1, rk2, rv, T, 0, tid); stage_store<96>(lds, 0, 0, rk1, rk2, rv, tid);
    stage_load<96>(rk1, rk2, rv, T, 64, tid);
    __syncthreads();
    int cur = 0, vcur = 0, vnext = 1, vfree = 2;
    f32x16 p0 = splat16(0.f), p1 = splat16(0.f); const bool lead = wid < 4;
#define MLA_SYNC(t_) do { if (VAR != 2) { if ((t_) + 1 < NT) stage_store<96>(lds, cur ^ 1, vnext, rk1, rk2, rv, tid); if ((t_) + 2 < NT) stage_load<96>(rk1, rk2, rv, T, ((t_) + 2) * 64, tid); } __syncthreads(); } while (0)
    for (int t = 0; t < NT; ++t) {
        const bool act = (VAR != 1) && t <= wtop;
        if (act) mla_qk<VAR>(t == wtop, lds + OFF_K + cur * KBUF, qf, t * 64, qidx, r, h, negm, p0, p1);
        if (!lead) MLA_SYNC(t);
        if (act) att_smpv<VAR>(t == 0, lds + OFF_V + vcur * VBUF, lane, p0, p1, m, l, negm, o);
        if (lead) MLA_SYNC(t);
        cur ^= 1; { const int tmp = vcur; vcur = vnext; vnext = vfree; vfree = tmp; }
    }
#undef MLA_SYNC
    l += __shfl_xor(l, 32);
    store_o(o, 1.0f / l, T.O + (size_t)qidx * T.opitch, h);
    __syncthreads();
}

template <int VAR> __device__ __forceinline__ void moba_qk(bool mask, bool lookup, const LAS unsigned char* Kb, const bf16x8* qf, const LAS float* btab, float b31, int s0, int qidx, bool rowsel,
                                        int r, int h, const f32x16& negm, f32x16& p0, f32x16& p1) {
    f32x16 c; const float cb = lookup ? 0.f : b31; bf16x8 kf[8];
    load_kfrags<64>(kf, Kb, r, h);
#pragma unroll
    for (int i = 0; i < 16; ++i) c[i] = negm[i] + cb;
    if (VAR != 4) qk_pre<64>(p0, p1, kf, qf, c); else { p0 = c; p1 = c; p0[0] += (float)kf[0][0] + (float)kf[7][7]; p1[1] += (float)kf[5][3]; }
    if (lookup) {
        asm volatile("" ::: "memory");
#pragma unroll
        for (int j = 0; j < 16; ++j) { const int rel = qidx - (s0 + crow(j, h)); const int r0 = min(max(rel, 0), 127), r1 = min(max(rel - 32, 0), 127); p0[j] += btab[r0]; p1[j] += btab[r1]; }
    }
    if (mask) {
        asm volatile("" ::: "memory");
#pragma unroll
        for (int j = 0; j < 16; ++j) { const int kv = s0 + crow(j, h); if (kv > qidx) p0[j] = -INFINITY; if (kv + 32 > qidx) p1[j] = -INFINITY; }
    }
    if (!__all(rowsel ? 1 : 0)) { asm volatile("" ::: "memory"); if (!rowsel) { p0 = splat16(-INFINITY); p1 = splat16(-INFINITY); } }
}
template <int VAR> __device__ __forceinline__ void moba_unit(LAS unsigned char* lds, const Tens& T, const float* kbp  , const LAS float* btab  ,
                                          int qb, int tid, int wid, int lane) {
    const int r = lane & 31, h = lane >> 5, own = qb, q0 = qb * 256, q0w = q0 + wid * 32, qidx = q0w + r;
    {
        const int n = tid >> 6, d = tid & 63; float s = 0.f;
        if (n < own) {
#pragma unroll
            for (int q4 = 0; q4 < 4; ++q4) s += kbp[(size_t)(n * 4 + q4) * 512 + d];
        }
        s *= (1.f / 256.f);
        const unsigned short hi = f2bf(s); const unsigned short lo = f2bf(s - bf2f(hi));
        *(LAS unsigned short*)(lds + OFF_KBH + n * KB_STR + d * 2) = hi; *(LAS unsigned short*)(lds + OFF_KBL + n * KB_STR + d * 2) = lo;
    }
    bf16x8 qf[4];
#pragma unroll
    for (int ks = 0; ks < 4; ++ks) qf[ks] = *(const GAS bf16x8*)(T.Q + (size_t)qidx * T.pitch + ks * 16 + h * 8);
    u32x4 rk1, rk2, rv; rk2 = (u32x4){0u, 0u, 0u, 0u};
    stage_load<64>(rk1, rk2, rv, T, own * 256, tid); stage_store<64>(lds, 0, 0, rk1, rk2, rv, tid);
    stage_load<64>(rk1, rk2, rv, T, own * 256 + 64, tid);
    __syncthreads();
    unsigned sel = 0u;
    {
        f32x16 g = splat16(0.f); const bf16x8 zf = (bf16x8){0, 0, 0, 0, 0, 0, 0, 0};
#pragma unroll
        for (int ks = 0; ks < 4; ++ks) {
            bf16x8 ah = *(const LAS bf16x8*)(lds + OFF_KBH + (r & 7) * KB_STR + ks * 32 + h * 16), al = *(const LAS bf16x8*)(lds + OFF_KBL + (r & 7) * KB_STR + ks * 32 + h * 16);
            if (r >= 8) { ah = zf; al = zf; }
            g = MFMA32(ah, qf[ks], g); g = MFMA32(al, qf[ks], g);
        }
        float gate[8];
#pragma unroll
        for (int i = 0; i < 4; ++i) { const float mine = g[i], other = __shfl_xor(mine, 32); gate[i] = h ? other : mine; gate[4 + i] = h ? mine : other; }
#pragma unroll
        for (int n = 0; n < 8; ++n) { int rank = 0;
#pragma unroll
            for (int j = 0; j < 8; ++j) if (j != n) rank += (j < own && (gate[j] > gate[n] || (gate[j] == gate[n] && j < n))) ? 1 : 0;
            if (n < own && rank < 3) sel |= 1u << n; }
    }
    f32x16 o[2]; o[0] = splat16(0.f); o[1] = splat16(0.f); f32x16 negm = splat16(0.f); float m = 0.f, l = 0.f;
    const float b31 = btab[127];
    const int nseq = 4 + 4 * own, adiag = wid >> 1;
    int cur = 0, vcur = 0, vnext = 1, vfree = 2;
    f32x16 p0 = splat16(0.f), p1 = splat16(0.f); const bool lead = wid < 4;
#define SEQT(i_) (((i_) < 4) ? own * 4 + (i_) : (i_) - 4)
#define MOBA_SYNC(i_) do { if (VAR != 2) { if ((i_) + 1 < nseq) stage_store<64>(lds, cur ^ 1, vnext, rk1, rk2, rv, tid); if ((i_) + 2 < nseq) stage_load<64>(rk1, rk2, rv, T, SEQT((i_) + 2) * 64, tid); } __syncthreads(); } while (0)
    for (int i = 0; i < nseq; ++i) {
        const int s0 = SEQT(i) * 64; const bool own_t = i < 4;
        const bool rowsel = own_t ? true : (((sel >> ((i - 4) >> 2)) & 1u) != 0u);
        const bool act = (VAR != 1) && (own_t ? (i <= adiag) : (__any(rowsel ? 1 : 0) != 0));
        if (act) moba_qk<VAR>(own_t && i == adiag, q0w - (s0 + 63) < 113, lds + OFF_K + cur * KBUF, qf, btab, b31, s0, qidx, rowsel, r, h, negm, p0, p1);
        if (!lead) MOBA_SYNC(i);
        if (act) att_smpv<VAR>(i == 0, lds + OFF_V + vcur * VBUF, lane, p0, p1, m, l, negm, o);
        if (lead) MOBA_SYNC(i);
        cur ^= 1; { const int tmp = vcur; vcur = vnext; vnext = vfree; vfree = tmp; }
    }
#undef MOBA_SYNC
#undef SEQT
    l += __shfl_xor(l, 32);
    store_o(o, 1.0f / l, T.O + (size_t)qidx * T.opitch, h);
    __syncthreads();
}

constexpr int SBW_V = 65536;
__device__ __forceinline__ void sbw_store(LAS unsigned char* lds, int slot, const u32x4& rk, const u32x4& rv, int tid) {
    const int row = tid >> 3, c = tid & 7;
    *(LAS u32x4*)(lds + slot * 8192 + row * 128 + ((c ^ ((row >> 1) & 7)) << 4)) = rk;
    *(LAS u32x4*)(lds + SBW_V + slot * 8192 + row * 128 + ((c ^ (((row >> 1) & 1) << 2)) << 4)) = rv;
}
__device__ __forceinline__ void sbw_load(u32x4& rk, u32x4& rv, const Tens& T, int s0, int tid) {
    const int row = tid >> 3, ch = tid & 7;
    rk = *(const GAS u32x4*)(T.K1 + (size_t)(s0 + row) * T.pitch + ch * 8);
    rv = *(const GAS u32x4*)(T.V + (size_t)(s0 + row) * T.pitch + ch * 8);
}
__device__ __forceinline__ void sb_tile(const LAS unsigned char* Kt, const LAS unsigned char* Vt, const bf16x8* qf, int s0, int qidx, bool mask, int r, int h, int lane, float& A, f32x16 (&o)[2]) {
    bf16x8 kf[8]; const int swz = (r >> 1) & 7;
#pragma unroll
    for (int ks = 0; ks < 4; ++ks) { const int cp = ((2 * ks + h) ^ swz) << 4; kf[2 * ks] = *(const LAS bf16x8*)(Kt + r * 128 + cp); kf[2 * ks + 1] = *(const LAS bf16x8*)(Kt + 4096 + r * 128 + cp); }
    __builtin_amdgcn_sched_barrier(0);
    f32x16 p0, p1; qk_pre<64>(p0, p1, kf, qf, splat16(0.f));
    if (mask) {
        asm volatile("" ::: "memory");
#pragma unroll
        for (int i = 0; i < 16; ++i) { if (!((s0 + crow(i, h)) < qidx)) p0[i] = -INFINITY; if (!((s0 + 32 + crow(i, h)) < qidx)) p1[i] = -INFINITY; }
    }
#pragma unroll
    for (int i = 0; i < 16; ++i) { p0[i] = __builtin_amdgcn_exp2f(fminf(p0[i], 30.f)); p1[i] = __builtin_amdgcn_exp2f(fminf(p1[i], 30.f)); }
    float gs[8], D01[8], Dg[8], tot[8], S[8];
#pragma unroll
    for (int g = 0; g < 4; ++g) {
        { const float d0 = 1.f + p0[4 * g], d1 = 1.f + p0[4 * g + 1], d2 = 1.f + p0[4 * g + 2], d3 = 1.f + p0[4 * g + 3]; D01[g] = d0 * d1; Dg[g] = D01[g] * (d2 * d3); gs[g] = -__builtin_amdgcn_logf(Dg[g]); }
        { const float d0 = 1.f + p1[4 * g], d1 = 1.f + p1[4 * g + 1], d2 = 1.f + p1[4 * g + 2], d3 = 1.f + p1[4 * g + 3]; D01[4 + g] = d0 * d1; Dg[4 + g] = D01[4 + g] * (d2 * d3); gs[4 + g] = -__builtin_amdgcn_logf(Dg[4 + g]); }
    }
#pragma unroll
    for (int j = 0; j < 8; ++j) { auto rr = __builtin_amdgcn_permlane32_swap(__float_as_uint(gs[j]), __float_as_uint(gs[j]), false, false); tot[j] = __uint_as_float(rr[0]) + __uint_as_float(rr[1]); }
    S[7] = 0.f;
#pragma unroll
    for (int j = 6; j >= 0; --j) S[j] = S[j + 1] + tot[j + 1];
    const float total = S[0] + tot[0];
#pragma unroll
    for (int j = 0; j < 8; ++j) {
        const float E = A + S[j] + (h == 0 ? (tot[j] - gs[j]) : 0.f);
        const float RS = __builtin_amdgcn_rcpf(Dg[j]) * __builtin_amdgcn_exp2f(E);
        const int g = j & 3;
        if (j < 4) { const float d0 = 1.f + p0[4 * g], d2 = 1.f + p0[4 * g + 2], t01 = RS * D01[j];
            p0[4 * g] = p0[4 * g] * RS; p0[4 * g + 1] = p0[4 * g + 1] * (RS * d0); p0[4 * g + 2] = p0[4 * g + 2] * t01; p0[4 * g + 3] = p0[4 * g + 3] * (t01 * d2); }
        else { const float d0 = 1.f + p1[4 * g], d2 = 1.f + p1[4 * g + 2], t01 = RS * D01[j];
            p1[4 * g] = p1[4 * g] * RS; p1[4 * g + 1] = p1[4 * g + 1] * (RS * d0); p1[4 * g + 2] = p1[4 * g + 2] * t01; p1[4 * g + 3] = p1[4 * g + 3] * (t01 * d2); }
    }
    VFrags vf;
    { const int blk = (lane >> 4) & 1, q = (lane & 15) >> 2, pp = lane & 3, vflip = (q >> 1) & 1;
      const LAS unsigned char* vb = Vt + (4 * h + q) * 128 + blk * 32 + pp * 8;
#pragma unroll
      for (int kb = 0; kb < 2; ++kb)
#pragma unroll
          for (int s = 0; s < 2; ++s)
#pragma unroll
              for (int db = 0; db < 2; ++db) { const int off = (kb * 32 + 16 * s) * 128 + ((db ^ vflip) << 6); vf.lo[(kb * 2 + s) * 2 + db] = vtr(vb + off); vf.hi[(kb * 2 + s) * 2 + db] = vtr(vb + off + 8 * 128); }
      __builtin_amdgcn_sched_barrier(0); }
    A += total;
    pv_pre(o, p0, p1, vf);
}
__device__ __forceinline__ void sb_unit(LAS unsigned char* lds, const Tens& T, int qb, int tid, int wid, int lane) {
    const int r = lane & 31, h = lane >> 5, q0 = qb * 256, q0w = q0 + wid * 32, qidx = q0w + r;
    const int ttop = qb * 4 + 3, wtop = (q0w + 31) / 64, tlo = (ttop >= 7) ? ttop - 7 : 0;
    {
        for (int s4 = 0; s4 <= ttop - tlo; s4 += 4) { u32x4 rk[4], rv[4];
#pragma unroll
            for (int j = 0; j < 4; ++j) sbw_load(rk[j], rv[j], T, (tlo + s4 + j) * 64, tid);
#pragma unroll
            for (int j = 0; j < 4; ++j) sbw_store(lds, s4 + j, rk[j], rv[j], tid); }
    }
    bf16x8 qf[4];
#pragma unroll
    for (int ks = 0; ks < 4; ++ks) qf[ks] = *(const GAS bf16x8*)(T.Q + (size_t)qidx * T.pitch + ks * 16 + h * 8);
    f32x16 o[2]; o[0] = splat16(0.f); o[1] = splat16(0.f); float A = 0.f; bool done = false;
    volatile LAS unsigned* flags = (volatile LAS unsigned*)(lds + OFF_FLAG);
    __syncthreads();
    for (int t = wtop; t >= tlo; --t) {
        sb_tile(lds + (t - tlo) * 8192, lds + SBW_V + (t - tlo) * 8192, qf, t * 64, qidx, t == wtop, r, h, lane, A, o);
        done = __all(A <= -150.f ? 1 : 0) != 0;
        if (done) break;
    }
    if (lane == 0) flags[16 + wid] = (done || tlo == 0) ? 1u : 0u;
    __syncthreads();
    unsigned alld = 1u;
#pragma unroll
    for (int w = 0; w < 8; ++w) alld &= flags[16 + w];
    if (!alld) {
        u32x4 rk, rv; sbw_load(rk, rv, T, (tlo - 1) * 64, tid); sbw_store(lds, 0, rk, rv, tid); __syncthreads();
        int cur = 0, par = 0;
        for (int t = tlo - 1;; --t) {
            const bool more = t > 0;
            if (more) sbw_load(rk, rv, T, (t - 1) * 64, tid);
            if (!done) { sb_tile(lds + cur * 8192, lds + SBW_V + cur * 8192, qf, t * 64, qidx, false, r, h, lane, A, o); done = __all(A <= -150.f ? 1 : 0) != 0; }
            if (lane == 0) flags[par * 8 + wid] = done ? 1u : 0u;
            if (more) sbw_store(lds, cur ^ 1, rk, rv, tid);
            __syncthreads();
            unsigned ad = 1u;
#pragma unroll
            for (int w = 0; w < 8; ++w) ad &= flags[par * 8 + w];
            if (!more || ad) break;
            cur ^= 1; par ^= 1;
        }
    }
    store_o(o, 1.0f, T.O + (size_t)qidx * T.opitch, h);
    __syncthreads();
}
__device__ __forceinline__ int next_unit(LAS unsigned char* lds, gu32* head, int tid) {
    volatile LAS unsigned* w = (volatile LAS unsigned*)(lds + OFF_WORK);
    if (tid == 0) *w = __hip_atomic_fetch_add(head, 1u, RLX_AGENT);
    __syncthreads();
    const int u = (int)*w;
    __syncthreads();
    return u;
}
}

struct Args { const float* in[16]; float* out; unsigned char* ws; int ph_lo, ph_hi; };
__global__ void __launch_bounds__(NWAVES * 64, 2) fwd(Args args) {
    extern __shared__ __attribute__((aligned(16))) unsigned char lds_raw[];
    LAS unsigned char* lds = (LAS unsigned char*)lds_raw;
    volatile LAS unsigned* MISC = (volatile LAS unsigned*)(lds + MISC_OFF);
    const int tid = threadIdx.x, lane = tid & 63, wave = __builtin_amdgcn_readfirstlane(tid >> 6), wave0 = wave;
    const int G = gridDim.x, bx = blockIdx.x, vcu = (G % 8 == 0) ? (bx % 8) * (G / 8) + bx / 8 : bx;
    const int gw = vcu * NWAVES + wave, NGW = G * NWAVES;
    unsigned char* ws = args.ws;
    gu32* ctl = (gu32*)(ws + WS_CTL);
    const float* x = args.in[0]; float* hbuf = args.out;
    bf16_t* XN = (bf16_t*)(ws + WS_XN); bf16_t* ATT = (bf16_t*)(ws + WS_ATT); bf16_t* BIG = (bf16_t*)(ws + WS_BIG);
    const int lo = args.ph_lo, hi = args.ph_hi;
    for (int u = tid; u < (LDS_BYTES - LDSCTL_OFF) / 4; u += NWAVES * 64) ((LAS unsigned*)(lds + LDSCTL_OFF))[u] = 0u;
    __syncthreads();
    XcdBarrier bar; bar.bar = (unsigned*)(ctl + CW_BAR); bar.x = 0; bar.st = nullptr;
    if (hi - lo > 1) bar = xcd_barrier_post((unsigned*)(ctl + CW_BAR), MISC + 8);
    int ph = 0;
#define PH_ON (ph >= lo && ph < hi)
#define GRID_BAR() do { XcdBarrier b_ = bar; unsigned long long bv_ = (unsigned long long)b_.bar; asm volatile("" : "+s"(bv_)); b_.bar = (unsigned*)bv_; xcd_barrier(b_); } while (0)
#define PH_END do { if (PH_ON && ph + 1 < hi) { GRID_BAR(); if (NREP(8) > 1) GRID_BAR(); } ++ph; } while (0)

    if (PH_ON) { for (int rep = 0; rep < NREP(6); ++rep) { if (rep) GRID_BAR();
        {
            LAS float* su = (LAS float*)lds; LAS float* si = (LAS float*)(lds + 8192);
            for (int fi = bx; fi < 896; fi += G) {
                const int e = fi / 448; int rr = fi % 448; const float* Win = args.in[5] + (size_t)e * 1024 * 2208; bf16_t* WT = (bf16_t*)(ws + WS_WCAT + e * SZ_WCAT);
                if (rr < 192) p0_fuse_item(Win, 0, 384, args.in[7] + (size_t)e * 384 * 768, 768, args.in[6] + e * 384, args.in[1] + 2 * e * DM, WT, rr / 16, rr % 16, false, SC_MLA, su, si, tid);
                else { rr -= 192; p0_fuse_item(Win, 384, 256, args.in[9] + (size_t)e * 256 * 1024, 1024, args.in[8] + e * 256, args.in[1] + 2 * e * DM, WT, rr / 16, rr % 16, true, 1.f, su, si, tid); }
            }
            __syncthreads();
        }
        LAS float* scr = (LAS float*)(lds + wave * 16384);
        constexpr int I0 = 16 * 69, I1 = 16 * 32, I2 = 16 * 96, I3 = 16 * 32, I4 = 16 * 176, I5 = 44 * 32;
        constexpr int NIT = 2 * (I0 + I1 + I2 + I3) + 4 * (I4 + I5);
        for (int it = gw; it < NIT; it += NGW) {
            int rr = it; int mat, N, K, inst; const float* W; bf16_t* WT; const float* gk = nullptr;
            if (rr < 2 * I0) { mat = 0; inst = rr / I0; rr %= I0; N = 2208; K = 1024; W = args.in[5] + (size_t)inst * 1024 * 2208; WT = (bf16_t*)(ws + WS_WCAT + inst * SZ_WCAT); gk = args.in[1] + 2 * inst * DM; }
            else if ((rr -= 2 * I0) < 2 * I1) { mat = 1; inst = rr / I1; rr %= I1; N = 1024; K = 1024; W = args.in[10] + (size_t)inst * 1024 * 1024; WT = (bf16_t*)(ws + WS_WOAB + inst * SZ_WO); }
            else if ((rr -= 2 * I1) < 2 * I2) { mat = 2; inst = rr / I2; rr %= I2; N = 3072; K = 1024; W = args.in[12] + (size_t)inst * 1024 * 3072; WT = (bf16_t*)(ws + WS_WQKV + inst * SZ_WQKV); gk = args.in[1] + (2 * inst + 1) * DM; }
            else if ((rr -= 2 * I2) < 2 * I3) { mat = 3; inst = rr / I3; rr %= I3; N = 1024; K = 1024; W = args.in[13] + (size_t)inst * 1024 * 1024; WT = (bf16_t*)(ws + WS_WOSB + inst * SZ_WO); }
            else if ((rr -= 2 * I3) < 4 * I4) { mat = 4; inst = rr / I4; rr %= I4; N = 5632; K = 1024; W = args.in[14] + (size_t)inst * 1024 * 5632; WT = (bf16_t*)(ws + WS_WGU + inst * SZ_WGU); gk = args.in[3] + inst * DM; }
            else { rr -= 4 * I4; mat = 5; inst = rr / I5; rr %= I5; N = 1024; K = 2816; W = args.in[15] + (size_t)inst * 2816 * 1024; WT = (bf16_t*)(ws + WS_WDN + inst * SZ_WDN); }
            const int nblk = N / 32, kb = rr / nblk, n0 = (rr % nblk) * 32; int dst; float sc; map_group(mat, n0, dst, sc);
            p0_tr_item(W, N, K, WT, kb, n0, dst, sc, gk, scr, lane);
        }
        for (int rw = gw; rw < 192; rw += NGW) {
            bf16_t* p = (bf16_t*)(ws + WS_WCAT + (rw / 96) * SZ_WCAT) + (size_t)(C_PAD + rw % 96) * 1024;
            ((GAS u32x4*)p)[lane] = (u32x4){0u, 0u, 0u, 0u}; ((GAS u32x4*)p)[64 + lane] = (u32x4){0u, 0u, 0u, 0u};
        }
        for (int idx = vcu * 512 + tid; idx < SEQ * 16; idx += G * 512) {
            const int pos = idx >> 4, i = idx & 15;
            const float inv = exp2f(-(float)i * (13.287712379549449f / 16.f)); const float ang = (float)pos * inv;
            const double rev = (double)ang * 0.15915494309189535; const float fr = (float)(rev - floor(rev));
            ((GAS float*)(ws + WS_ROPE))[2 * idx] = __builtin_amdgcn_cosf(fr); ((GAS float*)(ws + WS_ROPE))[2 * idx + 1] = __builtin_amdgcn_sinf(fr);
        }
        for (int m = gw; m < M; m += NGW) x_row_to_bf16(x + (size_t)m * DM, (bf16_t*)hbuf + (size_t)m * DM, (float*)(ws + WS_RSX) + m, lane);
    } }
    PH_END;

    unsigned char* const ws_top = ws;
    for (int L = 0; L < DEPTH; ++L) {
        const int e = L >> 1; const bool even = (L & 1) == 0;
        unsigned long long wsv = (unsigned long long)ws_top; asm volatile("" : "+s"(wsv)); unsigned char* ws = (unsigned char*)wsv;
        gu32* ctl = (gu32*)(ws + WS_CTL); bf16_t* XN = (bf16_t*)(ws + WS_XN); bf16_t* ATT = (bf16_t*)(ws + WS_ATT); bf16_t* BIG = (bf16_t*)(ws + WS_BIG);
        if (PH_ON) {
            const int N = even ? NPROJ : NQKV;
            pg8::Gemm g{(const bf16_t*)hbuf, (const bf16_t*)(ws + (even ? WS_WCAT + e * SZ_WCAT : WS_WQKV + e * SZ_WQKV)), M, N, DM};
            pg8::StaticOrder S; S.init(M, N, G, bx); pg8::EpiBf16 E{BIG, even ? PPROJ : PQKV, (const float*)(ws + WS_RSX)};
            for (int rep = 0; rep < NREP(0); ++rep) { if (rep) GRID_BAR();
            pg8::gemm_phase<pg8::EpiBf16, pg8::StaticOrder, true, true>(lds, g, S, E, fresh_tid(wave)); }
        }
        PH_END;
        if (even) {
            if (PH_ON) {
                const int lane = fresh_tid(wave) & 63;
                const float* cs = (const float*)(ws + WS_ROPE);
                { int m = gw;
                  for (; m + 3 * NGW < M; m += 4 * NGW) { const int pos[4] = {m & (SEQ - 1), (m + NGW) & (SEQ - 1), (m + 2 * NGW) & (SEQ - 1), (m + 3 * NGW) & (SEQ - 1)}; prep_rows<4>(BIG + (size_t)m * PPROJ, (size_t)NGW * PPROJ, cs, pos, lane); }
                  for (; m < M; m += NGW) { const int pos[1] = {m & (SEQ - 1)}; prep_rows<1>(BIG + (size_t)m * PPROJ, 0, cs, pos, lane); } }
                float* kbp = (float*)(ws + WS_KBP);
                for (int it = gw; it < 512; it += NGW) {
                    const int b = it >> 5, n = (it >> 2) & 7, q4 = it & 3;
                    const bf16_t* src = BIG + (size_t)(b * SEQ + n * 256 + q4 * 64) * PPROJ + C_MK + lane * 8; float a[8];
#pragma unroll
                    for (int j = 0; j < 8; ++j) a[j] = 0.f;
                    for (int r0 = 0; r0 < 64; r0 += 16) { u32x4 w[16];
#pragma unroll
                        for (int rr = 0; rr < 16; ++rr) w[rr] = *(const GAS u32x4*)(src + (size_t)(r0 + rr) * PPROJ);
#pragma unroll
                        for (int rr = 0; rr < 16; ++rr) { a[0] += bflo(w[rr].x); a[1] += bfhi(w[rr].x); a[2] += bflo(w[rr].y); a[3] += bfhi(w[rr].y); a[4] += bflo(w[rr].z); a[5] += bfhi(w[rr].z); a[6] += bflo(w[rr].w); a[7] += bfhi(w[rr].w); } }
                    float* dst = kbp + (size_t)((b * 8 + n) * 4 + q4) * 512 + lane * 8;
                    *(GAS f32x4*)dst = (f32x4){a[0], a[1], a[2], a[3]}; *(GAS f32x4*)(dst + 4) = (f32x4){a[4], a[5], a[6], a[7]};
                }
            }
            PH_END;
        }
        if (PH_ON) {
            const int tid = fresh_tid(wave0), lane = tid & 63, wave = wave0;
            if (even) {
                {
                    LAS float* bt = (LAS float*)(lds + att::OFF_BIAS);
                    for (int idx = tid; idx < 1024; idx += NWAVES * 64) { const int hh = idx >> 7, rel = idx & 127; int bk = rel;
                        if (rel >= 16) { bk = 15 + (rel >= 16) + (rel >= 19) + (rel >= 21) + (rel >= 24) + (rel >= 27) + (rel >= 31) + (rel >= 35) + (rel >= 40) + (rel >= 46) + (rel >= 52) + (rel >= 59) + (rel >= 67) + (rel >= 77) + (rel >= 87) + (rel >= 99) + (rel >= 113); }
                        bt[idx] = args.in[11][bk * 8 + hh] * LOG2E; }
                    __syncthreads();
                }
#define ATT_EVEN_PASS(VAR_, OB_, QO_) do { \
                gu32* head0 = ctl + CW_Q + 64 * (2 * L + (QO_)), * head1 = ctl + CW_Q + 64 * (2 * L + 1 + (QO_)); \
                { const int tid1 = fresh_tid(wave0), lane1 = tid1 & 63; \
                for (;;) {     \
                    const int u = att::next_unit(lds, head0, tid1); if (u >= 1024) break; \
                    const int qb = 7 - (u >> 7), bh = u & 127, b = bh >> 3, hh = bh & 7; \
                    const bf16_t* base = BIG + (size_t)b * SEQ * PPROJ; \
                    att::Tens T{base + C_Q + hh * 96, base + C_KN + hh * 64, base + C_KR, base + C_V + hh * 64, (OB_) + (size_t)b * SEQ * DM + hh * 64, PPROJ, DM}; \
                    att::mla_unit<VAR_>(lds, T, qb, tid1, wave0, lane1); \
                } } \
                { const int tid2 = fresh_tid(wave0), lane2 = tid2 & 63;     \
                for (;;) {     \
                    const int u = att::next_unit(lds, head1, tid2); if (u >= 1024) break; \
                    const int qb = 7 - (u >> 7), bh = u & 127, b = bh >> 3, hh = bh & 7; \
                    const bf16_t* base = BIG + (size_t)b * SEQ * PPROJ; \
                    att::Tens T{base + C_MQ + hh * 64, base + C_MK + hh * 64, nullptr, base + C_MV + hh * 64, (OB_) + (size_t)b * SEQ * DM + 512 + hh * 64, PPROJ, DM}; \
                    att::moba_unit<VAR_>(lds, T, (const float*)(ws + WS_KBP) + (size_t)b * 8 * 4 * 512 + hh * 64, (const LAS float*)(lds + att::OFF_BIAS) + hh * 128, qb, tid2, wave0, lane2); \
                } } } while (0)
#if (PROBE_DUP >> 1) & 1
                ATT_EVEN_PASS(PROBE_VAR, XN, 8); GRID_BAR();
#endif
                ATT_EVEN_PASS(0, ATT, 0);
#undef ATT_EVEN_PASS
            } else {
                for (int rep = 0; rep < NREP(2); ++rep) { if (rep) GRID_BAR();
                gu32* head0 = ctl + CW_Q + 64 * (2 * L + 8 * rep);
                for (;;) {
                    const int u = att::next_unit(lds, head0, tid); if (u >= 2048) break;
                    const int qb = 7 - (u >> 8), bh = u & 255, b = bh >> 4, hh = bh & 15;
                    const bf16_t* base = BIG + (size_t)b * SEQ * PQKV;
                    att::Tens T{base + hh * 64, base + 1024 + hh * 64, nullptr, base + 2048 + hh * 64, ATT + (size_t)b * SEQ * DM + hh * 64, PQKV, DM};
                    att::sb_unit(lds, T, qb, tid, wave, lane);
                }
                }
            }
        }
        PH_END;
        if (PH_ON) {
            pg8::Gemm g{ATT, (const bf16_t*)(ws + (even ? WS_WOAB : WS_WOSB) + e * SZ_WO), M, DM, DM};
            pg8::StaticOrder S; S.init(M, DM, G, bx); pg8::EpiBf16 E{BIG, DM, nullptr};
            for (int rep = 0; rep < NREP(3); ++rep) { if (rep) GRID_BAR();
            pg8::gemm_phase<pg8::EpiBf16, pg8::StaticOrder, true, true>(lds, g, S, E, fresh_tid(wave)); }
        }
        PH_END;
        if (PH_ON) {
            const int lane = fresh_tid(wave) & 63;
            bf16_t* h16 = (bf16_t*)hbuf; bf16_t* hmid = (bf16_t*)(ws + WS_BIG + 192 * MiB);
            for (int rep = 0; rep < NREP(7); ++rep) { if (rep) GRID_BAR();
            resnorm_phase<true>(h16, BIG, args.in[2] + L * DM, hmid, (float*)(ws + WS_RSY), gw, NGW, lane); }
        }
        PH_END;
        if (PH_ON) {
            pg8::Gemm g{(const bf16_t*)(ws + WS_BIG + 192 * MiB), (const bf16_t*)(ws + WS_WGU + L * SZ_WGU), M, 2 * DFF, DM};
            pg8::StaticOrder S; S.init(M, 2 * DFF, G, bx); pg8::EpiSwiGLU E{BIG, DFF, (const float*)(ws + WS_RSY)};
            for (int rep = 0; rep < NREP(4); ++rep) { if (rep) GRID_BAR();
            pg8::gemm_phase<pg8::EpiSwiGLU, pg8::StaticOrder, true, true>(lds, g, S, E, fresh_tid(wave)); }
        }
        PH_END;
        if (PH_ON) {
            pg8::Gemm g{BIG, (const bf16_t*)(ws + WS_WDN + L * SZ_WDN), M, DM, DFF};
            pg8::StaticOrder S; S.init(M, DM, G, bx); pg8::EpiBf16 E{ATT, DM, nullptr};
            for (int rep = 0; rep < NREP(5); ++rep) { if (rep) GRID_BAR();
            pg8::gemm_phase<pg8::EpiBf16, pg8::StaticOrder, true, true>(lds, g, S, E, fresh_tid(wave)); }
        }
        PH_END;
        if (PH_ON) {
            const int lane = fresh_tid(wave) & 63;
            const bf16_t* hmid = (const bf16_t*)(ws + WS_BIG + 192 * MiB);
            for (int rep = 0; rep < NREP(7); ++rep) { if (rep) GRID_BAR();
            if (L + 1 < DEPTH) resnorm_phase<true>(hmid, ATT, args.in[4] + L * DM, (bf16_t*)hbuf, (float*)(ws + WS_RSX), gw, NGW, lane);
            else resnorm_phase<false>(hmid, ATT, args.in[4] + L * DM, hbuf, nullptr, gw, NGW, lane); }
        }
        PH_END;
    }
#undef PH_ON
#undef PH_END
}

extern "C" void kernel_launch(void* const* d_in, const int* in_sizes, int n_in, void* d_out, int out_size, void* d_ws, size_t ws_size, hipStream_t stream) {
    static int grid = 0;
    if (grid == 0) {
        if (n_in != 16 || in_sizes[0] != M * DM || out_size != M * DM || ws_size < WS_END) { fprintf(stderr, "kernel_launch: unexpected shapes / workspace (n_in %d, ws %zu); nothing launched\n", n_in, ws_size); grid = -1; return; }
        int dev = 0, cus = 0;
        if (hipGetDevice(&dev) != hipSuccess || hipDeviceGetAttribute(&cus, hipDeviceAttributeMultiprocessorCount, dev) != hipSuccess) { grid = -1; return; }
        if (hipFuncSetAttribute((const void*)fwd, hipFuncAttributeMaxDynamicSharedMemorySize, LDS_BYTES) != hipSuccess) { fprintf(stderr, "kernel_launch: hipFuncSetAttribute failed\n"); grid = -1; return; }
        int per_cu = 0;
        if (hipOccupancyMaxActiveBlocksPerMultiprocessor(&per_cu, (const void*)fwd, NWAVES * 64, LDS_BYTES) != hipSuccess || per_cu < 1) { fprintf(stderr, "kernel_launch: occupancy query says %d blocks per CU\n", per_cu); }
        (void)hipGetLastError();
        grid = cus;
    }
    if (grid < 0) return;
    if (hipMemsetAsync((char*)d_ws + WS_CTL, 0, CTL_ZERO_BYTES, stream) != hipSuccess) return;
    Args a{};
    for (int i = 0; i < 16; ++i) a.in[i] = (const float*)d_in[i];
    a.out = (float*)d_out; a.ws = (unsigned char*)d_ws;
#if MK_PER_PHASE
    for (int p = 0; p < N_PHASES; ++p) { a.ph_lo = p; a.ph_hi = p + 1; hipLaunchKernelGGL(fwd, dim3(grid), dim3(NWAVES * 64), LDS_BYTES, stream, a); }
#else
    a.ph_lo = 0; a.ph_hi = N_PHASES;
    hipLaunchKernelGGL(fwd, dim3(grid), dim3(NWAVES * 64), LDS_BYTES, stream, a);
#endif
}
```
